# Optimizing an MI355X kernel written in HIP

```python
import jax, jax.numpy as jnp
from jax import lax
import numpy as np

D_MODEL = 1024
BATCH = 8
SEQ = 2048
DEPTH = 2

CHUNK = 64
Q_BLOCK = 128
N_A_LAYERS = (DEPTH + 1) // 2
N_B_LAYERS = DEPTH - N_A_LAYERS
A_HEADS = 16
A_HEAD_DIM = D_MODEL // A_HEADS
B_HEADS = 16
NOPE_DIM = 64
ROPE_DIM = 32
V_DIM = 64
Q_RANK = 768
KV_RANK = 256
ROPE_THETA = 10000.0
N_EXPERTS = 16
N_GROUPS = 4
EXPERTS_PER_GROUP = N_EXPERTS // N_GROUPS
GROUP_SCORE_TOP = 2
TOP_K = 2
D_EXPERT = 512
EPS = 1e-6

kernel_name = "fox_mla_yoco_grouped_moe_adaln"


def rmsnorm(x, g):
    xf = x.astype(jnp.float32)
    y = xf * lax.rsqrt(jnp.mean(xf * xf, axis=-1, keepdims=True) + EPS)
    return y.astype(x.dtype) * g


def modulate(h, shift, scale):
    return h * (1 + scale[:, None, :]) + shift[:, None, :]


def rope_tables(positions, dtype):
    half = ROPE_DIM // 2
    inv_freq = ROPE_THETA ** (-jnp.arange(half, dtype=jnp.float32) / half)
    ang = positions.astype(jnp.float32)[..., None] * inv_freq
    return jnp.cos(ang).astype(dtype), jnp.sin(ang).astype(dtype)


def apply_rope(x, cos, sin):
    x1, x2 = jnp.split(x, 2, axis=-1)
    return jnp.concatenate([x1 * cos - x2 * sin, x2 * cos + x1 * sin], axis=-1)


def block_sweep(attend, seq):
    return jnp.concatenate([attend(i * Q_BLOCK, (i + 1) * Q_BLOCK) for i in range(seq // Q_BLOCK)], axis=1)


def forgetting_attention(h, w_in, b_f, w_o):
    B, S, D = h.shape
    proj = h @ w_in
    q, k, v, f_logit = jnp.split(proj, [D, 2 * D, 3 * D], axis=-1)
    q = q.reshape(B, S, A_HEADS, A_HEAD_DIM)
    k = k.reshape(B, S, A_HEADS, A_HEAD_DIM)
    v = v.reshape(B, S, A_HEADS, A_HEAD_DIM)
    log_f = jax.nn.log_sigmoid((f_logit + b_f).astype(jnp.float32))
    cum = jnp.cumsum(log_f, axis=1).transpose(0, 2, 1)
    scale = A_HEAD_DIM ** -0.5
    pos = jnp.arange(S)

    def attend(t0, t1):
        s = jnp.einsum('bqhd,bkhd->bhqk', q[:, t0:t1], k[:, :t1], preferred_element_type=jnp.float32) * scale
        s = s + cum[:, :, t0:t1, None] - cum[:, :, None, :t1]
        allowed = pos[t0:t1, None] >= pos[None, :t1]
        p = jax.nn.softmax(jnp.where(allowed, s, -jnp.inf), axis=-1)
        return jnp.einsum('bhqk,bkhd->bqhd', p.astype(v.dtype), v[:, :t1])

    o = block_sweep(attend, S).reshape(B, S, D)
    return o @ w_o


def mla_shared_kv(x, c_act, norm_g, w_mod, b_mod, w_down, latent_g, w_up, cos, sin):
    B, S, _ = x.shape
    shift, scale = jnp.split(c_act @ w_mod + b_mod, 2, axis=-1)
    h = modulate(rmsnorm(x, norm_g), shift, scale)
    c_kv, k_rope = jnp.split(h @ w_down, [KV_RANK], axis=-1)
    c_kv = rmsnorm(c_kv, latent_g)
    kv = (c_kv @ w_up).reshape(B, S, B_HEADS, NOPE_DIM + V_DIM)
    k_nope, v = jnp.split(kv, [NOPE_DIM], axis=-1)
    k_rope = apply_rope(k_rope, cos, sin)
    return k_nope, k_rope, v


def latent_attention(h, k_nope, k_rope, v, w_dq, q_g, w_uq, w_o, cos, sin):
    B, S, _ = h.shape
    cq = rmsnorm(h @ w_dq, q_g)
    q = (cq @ w_uq).reshape(B, S, B_HEADS, NOPE_DIM + ROPE_DIM)
    q_nope, q_rope = jnp.split(q, [NOPE_DIM], axis=-1)
    q_rope = apply_rope(q_rope, cos[:, :, None, :], sin[:, :, None, :])
    scale = (NOPE_DIM + ROPE_DIM) ** -0.5
    chunk_id = jnp.arange(S) // CHUNK

    def attend(t0, t1):
        s = jnp.einsum('bqhd,bkhd->bhqk', q_nope[:, t0:t1], k_nope[:, :t1], preferred_element_type=jnp.float32)
        s = s + jnp.einsum('bqhr,bkr->bhqk', q_rope[:, t0:t1], k_rope[:, :t1], preferred_element_type=jnp.float32)
        allowed = chunk_id[t0:t1, None] >= chunk_id[None, :t1]
        p = jax.nn.softmax(jnp.where(allowed, s * scale, -jnp.inf), axis=-1)
        return jnp.einsum('bhqk,bkhd->bqhd', p.astype(v.dtype), v[:, :t1])

    o = block_sweep(attend, S).reshape(B, S, B_HEADS * V_DIM)
    return o @ w_o


def grouped_moe(h, router_w, router_bias, w_gate, w_up, w_down):
    B, S, D = h.shape
    hf = h.reshape(-1, D)
    n = hf.shape[0]
    scores = jax.nn.sigmoid(jnp.matmul(hf, router_w, preferred_element_type=jnp.float32))
    sel = (scores + router_bias.astype(jnp.float32)).reshape(n, N_GROUPS, EXPERTS_PER_GROUP)
    group_score = lax.top_k(sel, GROUP_SCORE_TOP)[0].sum(-1)
    g = jnp.argmax(group_score, axis=-1)
    g_idx = jnp.broadcast_to(g[:, None, None], (n, 1, EXPERTS_PER_GROUP))
    in_group = jnp.take_along_axis(sel, g_idx, axis=1)[:, 0]
    _, local = lax.top_k(in_group, TOP_K)
    idx = g[:, None] * EXPERTS_PER_GROUP + local
    w = jnp.take_along_axis(scores, idx, axis=1)
    w = w / jnp.sum(w, axis=-1, keepdims=True)
    combine = jnp.sum(jax.nn.one_hot(idx, N_EXPERTS, dtype=jnp.float32) * w[..., None], axis=1).astype(h.dtype)
    y = jnp.zeros_like(hf)
    for e in range(N_EXPERTS):
        a = jax.nn.silu(hf @ w_gate[e]) * (hf @ w_up[e])
        y = y + combine[:, e:e + 1] * (a @ w_down[e])
    return y.reshape(B, S, D)


def setup_inputs(seed: int = 0) -> dict:
    key = jax.random.key(seed)
    ks = iter(jax.random.split(key, 40))
    f32 = jnp.float32
    D = D_MODEL

    def w(shape, fan_in, gain=1.0):
        return gain * fan_in ** -0.5 * jax.random.normal(next(ks), shape, f32)

    def gain(shape):
        return 1.0 + 0.05 * jax.random.normal(next(ks), shape, f32)

    def small(shape, s):
        return s * jax.random.normal(next(ks), shape, f32)

    x = jax.random.normal(next(ks), (BATCH, SEQ, D), f32)
    c = jax.random.normal(next(ks), (BATCH, D), f32)
    offset = jax.random.randint(next(ks), (BATCH, 1), 0, 4096, dtype=jnp.int32)
    positions = (jnp.arange(SEQ, dtype=jnp.int32)[None, :] + offset).astype(jnp.int32)
    return {
        "x": x,
        "c": c,
        "positions": positions,
        "a_norm_g": gain((N_A_LAYERS, D)),
        "a_w_in": w((N_A_LAYERS, D, 3 * D + A_HEADS), D),
        "a_b_f": jax.random.uniform(next(ks), (N_A_LAYERS, A_HEADS), f32, 1.0, 5.0),
        "a_w_o": w((N_A_LAYERS, D, D), D),
        "kv_norm_g": gain((D,)),
        "kv_w_mod": w((D, 2 * D), D, 0.5),
        "kv_b_mod": small((2 * D,), 0.02),
        "kv_w_down": w((D, KV_RANK + ROPE_DIM), D),
        "kv_latent_g": gain((KV_RANK,)),
        "kv_w_up": w((KV_RANK, B_HEADS * (NOPE_DIM + V_DIM)), KV_RANK),
        "b_norm_g": gain((N_B_LAYERS, D)),
        "b_w_dq": w((N_B_LAYERS, D, Q_RANK), D),
        "b_q_norm_g": gain((N_B_LAYERS, Q_RANK)),
        "b_w_uq": w((N_B_LAYERS, Q_RANK, B_HEADS * (NOPE_DIM + ROPE_DIM)), Q_RANK),
        "b_w_o": w((N_B_LAYERS, B_HEADS * V_DIM, D), B_HEADS * V_DIM),
        "w_mod": w((DEPTH, D, 6 * D), D, 0.5),
        "b_mod": small((DEPTH, 6 * D), 0.02),
        "ffn_norm_g": gain((DEPTH, D)),
        "router_w": w((D, N_EXPERTS), D),
        "router_bias": small((N_EXPERTS,), 0.01),
        "exp_w_gate": w((DEPTH, N_EXPERTS, D, D_EXPERT), D),
        "exp_w_up": w((DEPTH, N_EXPERTS, D, D_EXPERT), D),
        "exp_w_down": w((DEPTH, N_EXPERTS, D_EXPERT, D), D_EXPERT),
        "final_norm_g": gain((D,)),
    }


def reference(x, c, positions, a_norm_g, a_w_in, a_b_f, a_w_o, kv_norm_g, kv_w_mod, kv_b_mod,
              kv_w_down, kv_latent_g, kv_w_up, b_norm_g, b_w_dq, b_q_norm_g, b_w_uq, b_w_o,
              w_mod, b_mod, ffn_norm_g, router_w, router_bias, exp_w_gate, exp_w_up, exp_w_down,
              final_norm_g):
    c_act = jax.nn.silu(c)
    cos, sin = rope_tables(positions, x.dtype)
    shared_kv = None
    for layer in range(DEPTH):
        sh1, sc1, g1, sh2, sc2, g2 = jnp.split(c_act @ w_mod[layer] + b_mod[layer], 6, axis=-1)
        if layer < N_A_LAYERS:
            h = modulate(rmsnorm(x, a_norm_g[layer]), sh1, sc1)
            mix = forgetting_attention(h, a_w_in[layer], a_b_f[layer], a_w_o[layer])
        else:
            j = layer - N_A_LAYERS
            h = modulate(rmsnorm(x, b_norm_g[j]), sh1, sc1)
            k_nope, k_rope, v = shared_kv
            mix = latent_attention(h, k_nope, k_rope, v, b_w_dq[j], b_q_norm_g[j], b_w_uq[j], b_w_o[j], cos, sin)
        x = x + g1[:, None, :] * mix
        h = modulate(rmsnorm(x, ffn_norm_g[layer]), sh2, sc2)
        x = x + g2[:, None, :] * grouped_moe(h, router_w, router_bias, exp_w_gate[layer], exp_w_up[layer], exp_w_down[layer])
        if layer == N_A_LAYERS - 1:
            shared_kv = mla_shared_kv(x, c_act, kv_norm_g, kv_w_mod, kv_b_mod, kv_w_down, kv_latent_g, kv_w_up, cos, sin)
    return rmsnorm(x, final_norm_g)
```

```cpp
#define MK_CUTS 1
#include <hip/hip_runtime.h>
#include <cstdio>
#include <cstdint>

#define LAS __attribute__((address_space(3)))
#define GAS __attribute__((address_space(1)))
typedef unsigned short bf16;
typedef short bf16x8 __attribute__((ext_vector_type(8)));
typedef short s16x4 __attribute__((ext_vector_type(4)));
typedef float f32x2 __attribute__((ext_vector_type(2)));
typedef float f32x4 __attribute__((ext_vector_type(4)));
typedef float f32x16 __attribute__((ext_vector_type(16)));
typedef unsigned u32x2 __attribute__((ext_vector_type(2)));
typedef unsigned u32x4 __attribute__((ext_vector_type(4)));
typedef GAS unsigned gu32;

constexpr int BATCH = 8, SEQ = 2048, D = 1024, M = BATCH * SEQ, NH = 16;
constexpr int NEXP = 16, DEXP = 512;
constexpr int QRANK = 768, KVRANK = 256, QCAT = NH * 96;
constexpr float EPS = 1e-6f;
constexpr float LOG2E = 1.4426950408889634f;
constexpr float C2_FOX = 0.125f * LOG2E;
constexpr float C2_MLA = 0.10206207261596575f * LOG2E;
constexpr int MODN = 14336;
constexpr int NWAVES = 8, NTHR = 512;

__device__ __forceinline__ unsigned cvt_pk_bf16(float lo, float hi) { unsigned r; asm volatile("v_cvt_pk_bf16_f32 %0, %1, %2" : "=v"(r) : "v"(lo), "v"(hi)); return r; }
__device__ __forceinline__ float bf16_to_f(unsigned short b) { return __uint_as_float(((unsigned)b) << 16); }
__device__ __forceinline__ float bflo(unsigned w) { return __uint_as_float(w << 16); }
__device__ __forceinline__ float bfhi(unsigned w) { return __uint_as_float(w & 0xffff0000u); }

namespace pg8 {
constexpr int BM = 256, BK = 64, HALF = 128, HTB = HALF * BK * 2, STAGE_BYTES = 8 * HTB, NXCD = 8, WGM = 8;
__host__ __device__ __forceinline__ int lds_byte(int r, int c) { const int st = (r >> 4) * 2 + (c >> 5), rr = r & 15, cc = c & 31, ob = rr * 64 + cc * 2; return st * 1024 + (ob ^ (((ob >> 9) & 1) << 5)); }
__host__ __device__ __forceinline__ void stage_rc(int b, int& R, int& C) { const int st = b / 1024, sb = b % 1024, swz = sb ^ (((sb >> 9) & 1) << 5); R = (st >> 1) * 16 + swz / 64; C = (st & 1) * 32 + (swz % 64) / 2; }
__host__ __device__ __forceinline__ int perm32(int rho) { const int n = rho >> 4, i = rho & 15; return 8 * (i >> 2) + 4 * n + (i & 3); }

struct Unit { int pm, pn; const char* A; const char* B; int aux; };

template <class Epi, class Sched, bool ALIGN_EPI>
__device__ __forceinline__ void gemm_phase(LAS unsigned char* lds, const int K, const Sched& S, const Epi& E) {
    int tid_ = threadIdx.x; asm volatile("" : "+v"(tid_));
    const int tid = tid_, wid = __builtin_amdgcn_readfirstlane(tid >> 6), lane = tid & 63, wr = wid >> 2, wc = wid & 3, fr = lane & 15, fq = lane >> 4;
    const int nt = K / BK;
    unsigned voffB[2];
#pragma unroll
    for (int i = 0; i < 2; ++i) { int R, C; stage_rc(tid * 16 + i * 8192, R, C); const int Rb = Epi::PERM ? ((R & ~31) + perm32(R & 31)) : R;
        voffB[i] = (unsigned)(Rb * K + C) * 2u; }
#define PG8_AOFF(dst, unit) do { int t_ = threadIdx.x; asm volatile("" : "+v"(t_)); _Pragma("unroll") for (int i_ = 0; i_ < 2; ++i_) { int R_, C_; stage_rc(t_ * 16 + i_ * 8192, R_, C_); \
        _Pragma("unroll") for (int h_ = 0; h_ < 2; ++h_) dst[h_][i_] = S.a_off(unit, h_ * HALF + R_, C_); } } while (0)
    const size_t kstep = (size_t)(BK * 2);
    const size_t hstep = (size_t)HALF * K * 2;
    const unsigned ldsw = (unsigned)wid * 1024u;
    const int aoff = lds_byte(wr * 64 + fr, fq * 8), boff = lds_byte(wc * 32 + fr, fq * 8);
#define PG8_SA(b, h) (((b) * 2 + (h)) * HTB)
#define PG8_SB(b, h) ((4 + (b) * 2 + (h)) * HTB)
#define PG8_STAGE(bufoff, gbase, voff) do { _Pragma("unroll") for (int _i = 0; _i < 2; ++_i) { unsigned _vo = (voff)[_i]; asm volatile("" : "+v"(_vo));   \
        __builtin_amdgcn_global_load_lds((const unsigned*)((const char*)(gbase) + _vo), (LAS unsigned*)(lds + (bufoff) + ldsw + _i * 8192), 16, 0, 0); } } while (0)
#define PG8_LDA(dst, b, h) do { _Pragma("unroll") for (int m = 0; m < 4; ++m) _Pragma("unroll") for (int k = 0; k < 2; ++k) dst[m][k] = *(const LAS bf16x8*)(lds + PG8_SA(b, h) + aoff + m * 2048 + k * 1024); } while (0)
#define PG8_LDB(dst, b, h) do { _Pragma("unroll") for (int n = 0; n < 2; ++n) _Pragma("unroll") for (int k = 0; k < 2; ++k) dst[n][k] = *(const LAS bf16x8*)(lds + PG8_SB(b, h) + boff + n * 2048 + k * 1024); } while (0)
#define PG8_MMA(ai, bj, At, Bt) do { __builtin_amdgcn_s_setprio(1); _Pragma("unroll") for (int m = 0; m < 4; ++m) _Pragma("unroll") for (int n = 0; n < 2; ++n) _Pragma("unroll") for (int k = 0; k < 2; ++k) \
        acc[ai][bj][m][n] = __builtin_amdgcn_mfma_f32_16x16x32_bf16(Bt[n][k], At[m][k], acc[ai][bj][m][n], 0, 0, 0); __builtin_amdgcn_s_setprio(0); } while (0)
#define PG8_WAIT_V(n) asm volatile("s_waitcnt vmcnt(" #n ")" ::: "memory")
#define PG8_WAIT_L(n) asm volatile("s_waitcnt lgkmcnt(" #n ")" ::: "memory")
#define PG8_BAR __builtin_amdgcn_s_barrier()
#define PG8_SCHED __builtin_amdgcn_sched_barrier(0)
    Unit cur, nxt; int ui = 0;
    if (!S.next(0, cur)) return;
    unsigned vAc[2][2], vAn[2][2];
    PG8_AOFF(vAc, cur);
    f32x4 acc[2][2][4][2];
#pragma unroll
    for (int a = 0; a < 2; ++a)
#pragma unroll
        for (int b = 0; b < 2; ++b)
#pragma unroll
            for (int m = 0; m < 4; ++m)
#pragma unroll
                for (int n = 0; n < 2; ++n) acc[a][b][m][n] = (f32x4){0.f, 0.f, 0.f, 0.f};
    bf16x8 At[4][2], B0[2][2], B1[2][2];
    const char* cA = cur.A; const char* cB = cur.B;
    PG8_STAGE(PG8_SB(0, 0), cB, voffB); PG8_STAGE(PG8_SB(0, 1), cB + hstep, voffB); PG8_STAGE(PG8_SA(0, 0), cA, vAc[0]); PG8_STAGE(PG8_SA(0, 1), cA, vAc[1]);
    if (wr == 1) PG8_BAR;
    PG8_WAIT_V(2); PG8_BAR;
    PG8_STAGE(PG8_SB(1, 0), cB + kstep, voffB); PG8_STAGE(PG8_SA(1, 0), cA + kstep, vAc[0]); PG8_STAGE(PG8_SB(1, 1), cB + hstep + kstep, voffB);
    PG8_WAIT_V(6); PG8_BAR;
    for (;;) {
        const bool has_next = S.next(ui + 1, nxt);
        if constexpr (Sched::EARLY_AOFF) {
            if (has_next) { PG8_AOFF(vAn, nxt); } else {
#pragma unroll
                for (int h = 0; h < 2; ++h)
#pragma unroll
                    for (int i = 0; i < 2; ++i) vAn[h][i] = vAc[h][i];
            }
        }
        const char* nA = has_next ? nxt.A : cA; const char* nB = has_next ? nxt.B : cB;
        for (int t = 0; t < nt; t += 2) {
            const bool last = (t == nt - 2);
            const char* a1 = cA + (size_t)(t + 1) * kstep;
            const char* a2 = last ? nA : cA + (size_t)(t + 2) * kstep; const char* b2 = last ? nB : cB + (size_t)(t + 2) * kstep;
            const char* a3 = a2 + kstep; const char* b3 = b2 + kstep;
            PG8_LDB(B0, 0, 0); PG8_LDB(B1, 0, 1); PG8_SCHED; PG8_LDA(At, 0, 0); PG8_STAGE(PG8_SA(1, 1), a1, vAc[1]);
            PG8_WAIT_V(8); PG8_WAIT_L(0); PG8_BAR; PG8_MMA(0, 0, At, B0); PG8_MMA(0, 1, At, B1); PG8_BAR; PG8_SCHED;
            if (last) {
                if constexpr (Sched::EARLY_AOFF) {
#pragma unroll
                    for (int h = 0; h < 2; ++h)
#pragma unroll
                        for (int i = 0; i < 2; ++i) vAc[h][i] = vAn[h][i];
                } else { if (has_next) PG8_AOFF(vAc, nxt); }
            }
            PG8_LDA(At, 0, 1); PG8_STAGE(PG8_SB(0, 0), b2, voffB); PG8_STAGE(PG8_SB(0, 1), b2 + hstep, voffB); PG8_STAGE(PG8_SA(0, 0), a2, vAc[0]);
            PG8_WAIT_V(8); PG8_WAIT_L(0); PG8_BAR; PG8_MMA(1, 0, At, B0); PG8_MMA(1, 1, At, B1); PG8_BAR; PG8_SCHED;
            PG8_LDB(B0, 1, 0); PG8_LDB(B1, 1, 1); PG8_SCHED; PG8_LDA(At, 1, 0); PG8_STAGE(PG8_SA(0, 1), a2, vAc[1]);
            PG8_WAIT_V(8); PG8_WAIT_L(0); PG8_BAR; PG8_MMA(0, 0, At, B0); PG8_MMA(0, 1, At, B1); PG8_BAR; PG8_SCHED;
            PG8_LDA(At, 1, 1); PG8_STAGE(PG8_SB(1, 0), b3, voffB); PG8_STAGE(PG8_SB(1, 1), b3 + hstep, voffB); PG8_STAGE(PG8_SA(1, 0), a3, vAc[0]);
            PG8_WAIT_V(8); PG8_WAIT_L(0); PG8_BAR; PG8_MMA(1, 0, At, B0); PG8_MMA(1, 1, At, B1); PG8_BAR; PG8_SCHED;
        }
        if constexpr (ALIGN_EPI) { if (wr == 0) PG8_BAR; }
        E(acc, cur, wr, wc, fr, fq);
        if (!has_next) break;
#pragma unroll
        for (int a = 0; a < 2; ++a)
#pragma unroll
            for (int b = 0; b < 2; ++b)
#pragma unroll
                for (int m = 0; m < 4; ++m)
#pragma unroll
                    for (int n = 0; n < 2; ++n) acc[a][b][m][n] = (f32x4){0.f, 0.f, 0.f, 0.f};
        cur = nxt; cA = nA; cB = nB; ++ui;
        if constexpr (ALIGN_EPI) { if (wr == 1) PG8_BAR; }
    }
    PG8_WAIT_V(0);
    if constexpr (!ALIGN_EPI) { if (wr == 0) PG8_BAR; }
    PG8_BAR;
#undef PG8_AOFF
#undef PG8_SA
#undef PG8_SB
#undef PG8_STAGE
#undef PG8_LDA
#undef PG8_LDB
#undef PG8_MMA
#undef PG8_WAIT_V
#undef PG8_WAIT_L
#undef PG8_BAR
#undef PG8_SCHED
}

struct StaticOrder {
    static constexpr bool EARLY_AOFF = true;
    const char* A; const char* Bt; int K, nM, nN, nwg, G, c;
    __device__ __forceinline__ void init(const void* A_, const void* Bt_, int Mr, int N, int K_, int G_, int c_) { A = (const char*)A_; Bt = (const char*)Bt_; K = K_; nM = Mr / BM; nN = N / BM; nwg = nM * nN; G = G_; c = c_; }
    __device__ __forceinline__ bool next(int i, Unit& u) const {
        const long L = (long)i * G + c; if (L >= nwg) return false;
        int wgid = (int)L; { const int q = nwg / NXCD, r = nwg % NXCD, xcd = wgid % NXCD, off = wgid / NXCD; wgid = (xcd < r ? xcd * (q + 1) : r * (q + 1) + (xcd - r) * q) + off; }
        const int nig = WGM * nN, gid = wgid / nig, fm = gid * WGM, gsz = (nM - fm) < WGM ? (nM - fm) : WGM;
        u.pm = fm + ((wgid % nig) % gsz); u.pn = (wgid % nig) / gsz; u.A = A; u.B = Bt + (size_t)u.pn * BM * K * 2; u.aux = 0; return true;
    }
    __device__ __forceinline__ unsigned a_off(const Unit& u, int r, int cc) const { return (unsigned)((u.pm * BM + r) * K + cc) * 2u; }
};
}

namespace attn {
constexpr int SLOT = 20480, NSLOT = 3, VOFF = 12288;
constexpr int LDS_WS = NSLOT * SLOT, LDS_OST = LDS_WS + 8 * 256, LDS_BYTES = LDS_OST + 8 * 4096;
struct Args { const bf16* Q; int qpitch, qhs; const bf16* K; const char* KA; int ka_rowb, ka_headb; const bf16* V; bf16* O; };
__device__ __forceinline__ int crow(int r, int hi) { return (r & 3) + 8 * (r >> 2) + 4 * hi; }
__device__ __forceinline__ void glds16(const void* gsrc, unsigned lds_dst) { unsigned keep;
    asm volatile("s_mov_b32 %0, m0\n\ts_mov_b32 m0, %2\n\ts_nop 0\n\tglobal_load_lds_dwordx4 %1, off\n\ts_mov_b32 m0, %0" : "=&s"(keep) : "v"(gsrc), "s"(lds_dst) : "memory"); }
typedef short v4i16_t __attribute__((ext_vector_type(4)));
__device__ __forceinline__ s16x4 vtr(const LAS char* p) { return __builtin_bit_cast(s16x4, __builtin_amdgcn_ds_read_tr16_b64_v4i16((LAS v4i16_t*)p)); }
#define ATT_WAIT_BAR(N) asm volatile("s_waitcnt vmcnt(" #N ") lgkmcnt(0)\n\ts_barrier" ::: "memory")

template <int MODE>
__device__ __forceinline__ void attn_unit(const int b, const int h, const int qb, const Args& T, LAS char* shm) {
    constexpr int NKS = (MODE == 0) ? 5 : 6, NCH = (MODE == 0) ? 9 : 12;
    const int tid = threadIdx.x, lane = tid & 63, r32 = lane & 31, hi = lane >> 5; const int wid = __builtin_amdgcn_readfirstlane(tid >> 6);
    const long rowbase = (long)b * SEQ; const int q0 = qb * 256;
    const int NT = 4 * qb + 4, myNT = 4 * qb + (wid >> 1) + 1;
    const unsigned lds0 = (unsigned)(uintptr_t)shm;
    LAS float* wsf = (LAS float*)(shm + LDS_WS) + wid * 64;
    bf16x8 qr[NKS];
    { const bf16* Qw = T.Q + (rowbase + q0 + wid * 32 + r32) * (long)T.qpitch + h * T.qhs;
#pragma unroll
      for (int d0 = 0; d0 < 4; ++d0) qr[d0] = *reinterpret_cast<const bf16x8*>(Qw + d0 * 16 + hi * 8);
      if constexpr (MODE == 0) { const short one = (short)0x3F80; qr[4] = hi == 0 ? (bf16x8){one, one, one, 0, 0, 0, 0, 0} : (bf16x8){0, 0, 0, 0, 0, 0, 0, 0}; }
      else {
#pragma unroll
        for (int d0 = 4; d0 < 6; ++d0) qr[d0] = *reinterpret_cast<const bf16x8*>(Qw + d0 * 16 + hi * 8); } }
    const char* src[3]; unsigned dsto[3]; unsigned stepb[3];
#pragma unroll
    for (int j = 0; j < 3; ++j) { const int p = wid + 8 * j;
        if (p < 8) { src[j] = (const char*)(T.K + (rowbase + lane) * 1024 + h * 64 + p * 8); stepb[j] = 64u * 2048u; dsto[j] = (unsigned)p * 1024u; }
        else if (p < NCH) { src[j] = T.KA + (rowbase + lane) * (long)T.ka_rowb + h * T.ka_headb + (p - 8) * 16; stepb[j] = 64u * (unsigned)T.ka_rowb; dsto[j] = (unsigned)p * 1024u; }
        else { const int v = (p - NCH) & 7; src[j] = (const char*)(T.V + (rowbase + 16 * (v & 3) + (lane >> 2)) * 1024 + h * 64 + (v >> 2) * 32 + (lane & 3) * 8); stepb[j] = 64u * 2048u; dsto[j] = (unsigned)(VOFF + v * 1024); } }
#define ATT_DMA(t, slotoff) do { _Pragma("unroll") for (int _j = 0; _j < 3; ++_j) \
        glds16(src[_j] + (size_t)(t) * stepb[_j], (unsigned)__builtin_amdgcn_readfirstlane(lds0 + (unsigned)(slotoff) + dsto[_j])); } while (0)
    ATT_DMA(0, 0); ATT_DMA(1, SLOT);
    float mrun = -INFINITY, lrun = 0.f; f32x16 o[2]; o[0] = f32x16{}; o[1] = f32x16{};
    int sl_cur = 0, sl_n2 = 2 * SLOT;
    const int qloc = 32 * (wid & 1) + r32;
    for (int t = 0; t < NT; ++t) {
        if (t + 1 < NT) { ATT_WAIT_BAR(3); } else { ATT_WAIT_BAR(0); }
        if (t + 2 < NT) ATT_DMA(t + 2, sl_n2);
        if (t < myNT) {
            const LAS char* sb = shm + sl_cur;
            f32x16 p0 = f32x16{}, p1 = f32x16{};
#pragma unroll
            for (int d0 = 0; d0 < NKS; ++d0) {
                const int c_off = (MODE == 0 && d0 == 4) ? 8 * 1024 : (2 * d0) * 1024 + hi * 1024;
                const LAS char* ka = sb + c_off + r32 * 16;
                const bf16x8 k0 = *(const LAS bf16x8*)(ka), k1 = *(const LAS bf16x8*)(ka + 512);
                p0 = __builtin_amdgcn_mfma_f32_32x32x16_bf16(k0, qr[d0], p0, 0, 0, 0);
                p1 = __builtin_amdgcn_mfma_f32_32x32x16_bf16(k1, qr[d0], p1, 0, 0, 0);
            }
            if constexpr (MODE == 0) {
                if (t == myNT - 1) {
#pragma unroll
                    for (int r = 0; r < 16; ++r) { const int kv = crow(r, hi); if (kv > qloc) p0[r] = -INFINITY; if (kv + 32 > qloc) p1[r] = -INFINITY; }
                }
            }
            float mx = fmaxf(p0[0], p1[0]);
#pragma unroll
            for (int r = 1; r < 16; ++r) mx = fmaxf(mx, fmaxf(p0[r], p1[r]));
            mx = fmaxf(mx, __shfl_xor(mx, 32));
            const float mnew = fmaxf(mrun, mx);
            if (__any(mnew > mrun)) {
                const float f = __builtin_amdgcn_exp2f(mrun - mnew);
                lrun *= f; mrun = mnew;
                if (hi == 0) wsf[r32] = f;
#pragma unroll
                for (int j = 0; j < 4; ++j) { const f32x4 fv = *(const LAS f32x4*)(wsf + 8 * j + 4 * hi);
#pragma unroll
                    for (int i = 0; i < 4; ++i) { o[0][4 * j + i] *= fv[i]; o[1][4 * j + i] *= fv[i]; } }
            }
            float sacc = 0.f;
#pragma unroll
            for (int r = 0; r < 16; ++r) { p0[r] = __builtin_amdgcn_exp2f(p0[r] - mrun); p1[r] = __builtin_amdgcn_exp2f(p1[r] - mrun); sacc += p0[r] + p1[r]; }
            lrun += sacc;
            u32x4 pw[4];
#pragma unroll
            for (int i = 0; i < 4; ++i) { pw[0][i] = cvt_pk_bf16(p0[2 * i], p0[2 * i + 1]); pw[1][i] = cvt_pk_bf16(p0[8 + 2 * i], p0[9 + 2 * i]);
                                          pw[2][i] = cvt_pk_bf16(p1[2 * i], p1[2 * i + 1]); pw[3][i] = cvt_pk_bf16(p1[8 + 2 * i], p1[9 + 2 * i]); }
            const LAS char* vp = sb + VOFF + ((lane >> 4) & 1) * 32 + (lane & 3) * 8 + (4 * hi + ((lane & 15) >> 2)) * 64;
#pragma unroll
            for (int d0 = 0; d0 < 2; ++d0)
#pragma unroll
                for (int ks = 0; ks < 4; ++ks) {
                    const s16x4 lo = vtr(vp + d0 * 4096 + ks * 1024), hh = vtr(vp + d0 * 4096 + ks * 1024 + 512);
                    const bf16x8 vf = (bf16x8){lo[0], lo[1], lo[2], lo[3], hh[0], hh[1], hh[2], hh[3]};
                    o[d0] = __builtin_amdgcn_mfma_f32_32x32x16_bf16(__builtin_bit_cast(bf16x8, pw[ks]), vf, o[d0], 0, 0, 0);
                }
        }
        sl_cur = (sl_cur == 2 * SLOT) ? 0 : sl_cur + SLOT; sl_n2 = (sl_n2 == 2 * SLOT) ? 0 : sl_n2 + SLOT;
    }
    lrun += __shfl_xor(lrun, 32);
    if (hi == 0) wsf[r32] = 1.0f / lrun;
    float rli[16];
#pragma unroll
    for (int j = 0; j < 4; ++j) { const f32x4 fv = *(const LAS f32x4*)(wsf + 8 * j + 4 * hi); rli[4 * j] = fv[0]; rli[4 * j + 1] = fv[1]; rli[4 * j + 2] = fv[2]; rli[4 * j + 3] = fv[3]; }
    LAS bf16* stg = (LAS bf16*)(shm + LDS_OST) + wid * 2048;
#pragma unroll
    for (int r = 0; r < 16; ++r) { const int orow = crow(r, hi);
#pragma unroll
        for (int d0 = 0; d0 < 2; ++d0) stg[orow * 64 + d0 * 32 + r32] = (bf16)(cvt_pk_bf16(o[d0][r] * rli[r], 0.f) & 0xffffu); }
    bf16* Ow = T.O + (rowbase + q0 + wid * 32) * 1024 + h * 64;
#pragma unroll
    for (int i = 0; i < 4; ++i) { const int row = i * 8 + (lane >> 3), ch = lane & 7; const u32x4 v = *(const LAS u32x4*)(stg + row * 64 + ch * 8); *(u32x4*)(Ow + (long)row * 1024 + ch * 8) = v; }
    asm volatile("s_waitcnt lgkmcnt(0)\n\ts_barrier" ::: "memory");
#undef ATT_DMA
}
template <int MODE>
__device__ __forceinline__ void attn_phase(LAS char* lds, const Args& T, int vcu, int G) {
    for (int pu = vcu; pu < BATCH * NH * 4; pu += G) { const int bh = pu >> 2, s = pu & 3;
        attn_unit<MODE>(bh / NH, bh % NH, s, T, lds);
        attn_unit<MODE>(bh / NH, bh % NH, 7 - s, T, lds); }
}
#undef ATT_WAIT_BAR
}

constexpr size_t MiB = 1u << 20;
constexpr size_t WS_CTL = 0, CTL_ZERO_BYTES = 1 * MiB;
constexpr int CW_TMO = 0, CW_BAR = 4096, CW_CNT = 8192;
constexpr size_t WS_SSKV = 256 * 1024, WS_SSQ = 320 * 1024;
constexpr size_t WS_ROPE = 1 * MiB;
constexpr size_t WS_MODP = 3 * MiB;
constexpr size_t WS_MODF = 7 * MiB - 512 * 1024;
constexpr size_t WS_LF = 7 * MiB;
constexpr size_t WS_ROUTE = 8 * MiB;
constexpr size_t WS_LIST = 8 * MiB + 512 * 1024;
constexpr size_t WS_WLIST = 9 * MiB + 512 * 1024;
constexpr size_t WS_KB = 10 * MiB + 512 * 1024;
constexpr size_t WS_KR = 14 * MiB + 512 * 1024;
constexpr size_t WS_W = 16 * MiB;
constexpr size_t WS_WIN = WS_W, WS_WO0 = WS_WIN + 6 * MiB, WS_WDN = WS_WO0 + 2 * MiB, WS_WUP = WS_WDN + 512 * 1024, WS_WDQ = WS_WUP + 1 * MiB,
                 WS_WUQ = WS_WDQ + 1536 * 1024, WS_WO1 = WS_WUQ + 2304 * 1024;
static_assert(WS_WO1 + 2 * MiB <= 32 * MiB, "weights");
constexpr size_t WS_EW = 32 * MiB;
constexpr size_t EW_LAYER = 48 * MiB, EW_D = 32 * MiB;
constexpr size_t WS_XR = 128 * MiB;
constexpr size_t WS_T = 192 * MiB;
constexpr size_t WS_H = WS_T, WS_Q = WS_T + 32 * MiB, WS_K = WS_T + 64 * MiB, WS_V = WS_T + 96 * MiB;
constexpr size_t WS_ACT = WS_T + 32 * MiB, WS_Y = WS_T + 68 * MiB;
constexpr size_t WS_HKV = WS_T, WS_H1 = WS_T + 32 * MiB, WS_CKV = WS_T + 118 * MiB, WS_CQ = WS_T + 126 * MiB;
constexpr size_t WS_QCAT = WS_T, WS_KN = WS_T + 48 * MiB, WS_V2 = WS_T + 80 * MiB, WS_O2 = WS_T + 118 * MiB;
constexpr size_t WS_END = WS_T + 150 * MiB;
static_assert(WS_Y + (size_t)36864 * 1024 * 2 <= WS_END && WS_CQ + (size_t)M * QRANK * 2 <= WS_END && WS_V2 + 32 * MiB <= WS_CKV && WS_O2 + 32 * MiB <= WS_END, "ws map");
constexpr int MOE_ROWS = 36864;

constexpr int LDS_BYTES = 160 * 1024;
constexpr int LDS_MISC = LDS_BYTES - 1024;
static_assert(pg8::STAGE_BYTES <= LDS_MISC && attn::LDS_BYTES <= LDS_MISC, "lds");

#define RLX_AGENT __ATOMIC_RELAXED, __HIP_MEMORY_SCOPE_AGENT

#define XB_TMO      128
#define XB_XCNT(j)  (256  + 64 * (j))
#define XB_XSUB(j)  (1280 + 64 * (j))
#define XB_XGEN(j)  (2304 + 64 * (j))
#define XB_TOP      3328
#define XB_TOPGEN   3392
#define XCD_BAR_WORDS 3456
#define XB_SPIN_CAP (1u << 18)

__device__ __forceinline__ unsigned xb_ld(unsigned* p)              { return __hip_atomic_load(p, __ATOMIC_RELAXED, __HIP_MEMORY_SCOPE_AGENT); }
__device__ __forceinline__ unsigned xb_add(unsigned* p, unsigned v) { return __hip_atomic_fetch_add(p, v, __ATOMIC_RELAXED, __HIP_MEMORY_SCOPE_AGENT); }
__device__ __forceinline__ unsigned xb_xcc_id() { return (unsigned)__builtin_amdgcn_s_getreg((3 << 11) | 20) & 0xFu; }
#define XB_SPIN(cond, bar) do { unsigned _sp = 0; while (cond) { __builtin_amdgcn_s_sleep(1); \
    if ((++_sp & 255u) == 0u) { if (xb_ld(&(bar)[XB_TMO])) break; if (_sp > XB_SPIN_CAP) { atomicAdd(&(bar)[XB_TMO], 1u); break; } } } } while (0)

struct XcdBarrier {
    unsigned* bar; unsigned x;
    volatile LAS unsigned* st;
};

__device__ __forceinline__ XcdBarrier xcd_barrier_post(unsigned* bar, volatile LAS unsigned* st) {
    XcdBarrier b; b.bar = bar; b.x = xb_xcc_id(); b.st = st;
    if (threadIdx.x == 0) (void)xb_add(&bar[XB_XCNT(b.x)], 1u);
    return b;
}
__device__ __forceinline__ void xcd_barrier_complete(unsigned* bar, unsigned x, unsigned& nloc, unsigned& nx) {
    const unsigned G = gridDim.x * gridDim.y * gridDim.z;
    unsigned sum, cnt, mine, sp = 0u;
    for (;;) {
        sum = 0u; cnt = 0u; mine = 0u;
#pragma unroll
        for (unsigned j = 0; j < 16; ++j) { const unsigned c = xb_ld(&bar[XB_XCNT(j)]); sum += c; cnt += (c > 0u) ? 1u : 0u; mine = (j == x) ? c : mine; }
        if (sum == G) break;
        __builtin_amdgcn_s_sleep(1);
        if ((++sp & 255u) == 0u) { if (xb_ld(&bar[XB_TMO])) break; if (sp > XB_SPIN_CAP) { atomicAdd(&bar[XB_TMO], 1u); break; } }
    }
    nloc = mine > 0u ? mine : 1u; nx = cnt > 0u ? cnt : 1u;
}

__device__ __forceinline__ void xcd_barrier(const XcdBarrier& b) {
    asm volatile("s_waitcnt vmcnt(0)" ::: "memory");
    __syncthreads();
    if (threadIdx.x == 0) {
        unsigned* bar = b.bar;
        __builtin_amdgcn_s_waitcnt(0);
        unsigned nloc = b.st[0], nx = b.st[1];
        if (nloc == 0u) { xcd_barrier_complete(bar, b.x, nloc, nx); b.st[0] = nloc; b.st[1] = nx; }
        const unsigned old = xb_add(&bar[XB_XSUB(b.x)], 1u);
        const unsigned gen = old / nloc;
        if (old + 1u == (gen + 1u) * nloc) {
            __builtin_amdgcn_fence(__ATOMIC_RELEASE, "agent");
            asm volatile("s_waitcnt vmcnt(0)" ::: "memory");
            const unsigned og = xb_add(&bar[XB_TOP], 1u);
            const unsigned tg = og / nx;
            if (og + 1u == (tg + 1u) * nx) xb_add(&bar[XB_TOPGEN], 1u);
            else XB_SPIN(xb_ld(&bar[XB_TOPGEN]) == tg, bar);
            __builtin_amdgcn_fence(__ATOMIC_ACQUIRE, "agent");
            xb_add(&bar[XB_XGEN(b.x)], 1u);
            asm volatile("s_waitcnt vmcnt(0)" ::: "memory");
        } else {
            XB_SPIN(xb_ld(&bar[XB_XGEN(b.x)]) == gen, bar);
            __builtin_amdgcn_fence(__ATOMIC_ACQUIRE, "agent");
            asm volatile("s_waitcnt vmcnt(0)" ::: "memory");
        }
    }
    __syncthreads();
}

struct Args { const void* in[27]; float* out; unsigned char* ws; int ph_lo, ph_hi; };
enum { I_X = 0, I_C, I_POS, I_A_NORM_G, I_A_W_IN, I_A_B_F, I_A_W_O, I_KV_NORM_G, I_KV_W_MOD, I_KV_B_MOD, I_KV_W_DOWN, I_KV_LATENT_G, I_KV_W_UP, I_B_NORM_G, I_B_W_DQ, I_B_Q_NORM_G,
       I_B_W_UQ, I_B_W_O, I_W_MOD, I_B_MOD, I_FFN_NORM_G, I_ROUTER_W, I_ROUTER_BIAS, I_EXP_W_GATE, I_EXP_W_UP, I_EXP_W_DOWN, I_FINAL_NORM_G };

__device__ __forceinline__ float wave_sum(float v) {
#pragma unroll
    for (int o = 1; o < 64; o <<= 1) v += __shfl_xor(v, o);
    return v;
}
__device__ __forceinline__ float mod_bias(const Args& a, int n) {
    return n < 12288 ? ((const float*)a.in[I_B_MOD])[n] : ((const float*)a.in[I_KV_B_MOD])[n - 12288];
}
__device__ __forceinline__ float mod_value(const Args& a, int b, int n) {
    const float* mp = (const float*)(a.ws + WS_MODP) + (size_t)b * MODN + n; float s = mod_bias(a, n);
#pragma unroll
    for (int kc = 0; kc < 8; ++kc) s += mp[(size_t)kc * 8 * MODN];
    return s;
}

template <class ColPtr>
__device__ __forceinline__ void transpose_item(const ColPtr& colptr, const int ld, const int K, bf16* WT, const float* kscale, LAS float* scr, const int kb, const int nb, const int lane) {
    const int k0 = 64 * kb, n0 = 32 * nb;
    const float* cp = colptr(n0 + (lane & 31)) + (size_t)(k0 + (lane >> 5)) * ld;
#pragma unroll 8
    for (int i = 0; i < 32; ++i) { const int kk = 2 * i + (lane >> 5); float v = cp[(size_t)(2 * i) * ld]; if (kscale) v *= kscale[k0 + kk]; scr[kk * 33 + (lane & 31)] = v; }
    asm volatile("s_waitcnt lgkmcnt(0)" ::: "memory");
    const int c = lane & 7;
#pragma unroll
    for (int j = 0; j < 4; ++j) { const int n = (lane >> 3) + 8 * j; const LAS float* s = scr + (8 * c) * 33 + n;
        u32x4 o; o.x = cvt_pk_bf16(s[0 * 33], s[1 * 33]); o.y = cvt_pk_bf16(s[2 * 33], s[3 * 33]); o.z = cvt_pk_bf16(s[4 * 33], s[5 * 33]); o.w = cvt_pk_bf16(s[6 * 33], s[7 * 33]);
        *(u32x4*)(WT + (size_t)(n0 + n) * K + k0 + 8 * c) = o; }
    asm volatile("s_waitcnt lgkmcnt(0)" ::: "memory");
}

__device__ __forceinline__ void p0_prologue(const Args& a, LAS unsigned char* lds, const int gw, const int NGW, const int wave, const int lane, const int tid) {
    unsigned char* ws = a.ws;
    LAS float* cT = (LAS float*)(lds + 69632);
    { const float* c = (const float*)a.in[I_C];
      for (int idx = tid; idx < 8 * 1024; idx += NTHR) { const int b = idx >> 10, k = idx & 1023; const float v = c[idx]; cT[k * 8 + b] = v / (1.f + __expf(-v)); } }
    __syncthreads();
    LAS float* scr = (LAS float*)(lds + wave * 8448);
    constexpr int I_MODT = 224 * 8;
    constexpr int I_WIN = 16 * 96, I_WO = 16 * 32, I_WDN = 16 * 8, I_WUP = 4 * 64, I_WDQ = 16 * 24, I_WUQ = 12 * 48, I_GU = 32 * 512, I_DN = 32 * 256;
    constexpr int NITEMS = I_MODT + I_WIN + I_WO + I_WDN + I_WUP + I_WDQ + I_WUQ + I_WO + I_GU + I_DN;
    for (int it = gw; it < NITEMS; it += NGW) {
        int r = it;
        if (r < I_MODT) {
            const int cg = r >> 3, kc = r & 7, k0 = kc * 128;
            const float* W; int ld, col0;
            if (cg < 96) { W = (const float*)a.in[I_W_MOD]; ld = 6144; col0 = cg * 64; }
            else if (cg < 192) { W = (const float*)a.in[I_W_MOD] + (size_t)1024 * 6144; ld = 6144; col0 = (cg - 96) * 64; }
            else { W = (const float*)a.in[I_KV_W_MOD]; ld = 2048; col0 = (cg - 192) * 64; }
            const float* wp = W + (size_t)k0 * ld + col0 + lane;
            float acc[8] = {0.f, 0.f, 0.f, 0.f, 0.f, 0.f, 0.f, 0.f};
#pragma unroll 8
            for (int kk = 0; kk < 128; ++kk) { const float w = wp[(size_t)kk * ld]; const f32x4 c0 = *(const LAS f32x4*)(cT + (k0 + kk) * 8), c1 = *(const LAS f32x4*)(cT + (k0 + kk) * 8 + 4);
                acc[0] += c0[0] * w; acc[1] += c0[1] * w; acc[2] += c0[2] * w; acc[3] += c0[3] * w; acc[4] += c1[0] * w; acc[5] += c1[1] * w; acc[6] += c1[2] * w; acc[7] += c1[3] * w; }
            float* mp = (float*)(ws + WS_MODP) + (size_t)kc * 8 * MODN + cg * 64 + lane;
#pragma unroll
            for (int b = 0; b < 8; ++b) mp[(size_t)b * MODN] = acc[b];
            continue;
        }
        r -= I_MODT;
        if (r < I_WIN) { const float* W = (const float*)a.in[I_A_W_IN]; transpose_item([=](int n) { return W + n; }, 3088, 1024, (bf16*)(ws + WS_WIN), nullptr, scr, r / 96, r % 96, lane); continue; } r -= I_WIN;
        if (r < I_WO) { const float* W = (const float*)a.in[I_A_W_O]; transpose_item([=](int n) { return W + n; }, 1024, 1024, (bf16*)(ws + WS_WO0), nullptr, scr, r / 32, r % 32, lane); continue; } r -= I_WO;
        if (r < I_WDN) { const float* W = (const float*)a.in[I_KV_W_DOWN]; transpose_item([=](int n) { return W + n; }, 288, 1024, (bf16*)(ws + WS_WDN), nullptr, scr, r / 8, r % 8, lane); continue; } r -= I_WDN;
        if (r < I_WUP) { const float* W = (const float*)a.in[I_KV_W_UP];
            transpose_item([=](int n) { const int nn = n & 1023, hh = nn >> 6, j = nn & 63; return W + hh * 128 + (n >> 10) * 64 + j; }, 2048, 256, (bf16*)(ws + WS_WUP), (const float*)a.in[I_KV_LATENT_G], scr, r / 64, r % 64, lane); continue; } r -= I_WUP;
        if (r < I_WDQ) { const float* W = (const float*)a.in[I_B_W_DQ]; transpose_item([=](int n) { return W + n; }, 768, 1024, (bf16*)(ws + WS_WDQ), nullptr, scr, r / 24, r % 24, lane); continue; } r -= I_WDQ;
        if (r < I_WUQ) { const float* W = (const float*)a.in[I_B_W_UQ];
            transpose_item([=](int n) { const int hh = n / 96, j = n - hh * 96; const int sc = j < 64 ? j : 64 + ((j - 64) & 1) * 16 + ((j - 64) >> 1); return W + hh * 96 + sc; }, 1536, 768, (bf16*)(ws + WS_WUQ), (const float*)a.in[I_B_Q_NORM_G], scr, r / 48, r % 48, lane); continue; } r -= I_WUQ;
        if (r < I_WO) { const float* W = (const float*)a.in[I_B_W_O]; transpose_item([=](int n) { return W + n; }, 1024, 1024, (bf16*)(ws + WS_WO1), nullptr, scr, r / 32, r % 32, lane); continue; } r -= I_WO;
        if (r < I_GU) { const int le = r >> 9, q = r & 511; const float* Wg = (const float*)a.in[I_EXP_W_GATE] + (size_t)le * 1024 * 512; const float* Wu = (const float*)a.in[I_EXP_W_UP] + (size_t)le * 1024 * 512;
            bf16* dst = (bf16*)(ws + WS_EW + (size_t)(le >> 4) * EW_LAYER) + (size_t)(le & 15) * 1024 * 1024;
            transpose_item([=](int n) { const int tt = n >> 8, u = (n >> 7) & 1, j = n & 127; return (u ? Wu : Wg) + tt * 128 + j; }, 512, 1024, dst, nullptr, scr, q / 32, q % 32, lane); continue; } r -= I_GU;
        { const int le = r >> 8, q = r & 255; const float* Wd = (const float*)a.in[I_EXP_W_DOWN] + (size_t)le * 512 * 1024;
            bf16* dst = (bf16*)(ws + WS_EW + (size_t)(le >> 4) * EW_LAYER + EW_D) + (size_t)(le & 15) * 1024 * 512;
            transpose_item([=](int n) { return Wd + n; }, 1024, 512, dst, nullptr, scr, q / 32, q % 32, lane); }
    }
    { const int* pos = (const int*)a.in[I_POS]; f32x2* tab = (f32x2*)(ws + WS_ROPE);
      for (int idx = gw * 64 + lane; idx < M * 16; idx += NGW * 64) { const int tok = idx >> 4, i = idx & 15;
          const float invf = exp2f(-(float)i * (13.287712379549449f / 16.0f)); const float ang = (float)pos[tok] * invf; tab[idx] = (f32x2){cosf(ang), sinf(ang)}; } }
}

template <int N> __device__ __forceinline__ float wave_reduce_multi(float (&v)[N], const int lane) {
    int n = N;
#pragma unroll
    for (int s = 32; n > 1; s >>= 1, n >>= 1) { const int half = n >> 1; const bool up = (lane & s) != 0;
#pragma unroll
        for (int i = 0; i < N / 2; ++i) if (i < half) { const float a = v[i], b = v[i + half]; const float send = up ? a : b, keep = up ? b : a; v[i] = keep + __shfl_xor(send, s); } }
    float r = v[0];
#pragma unroll
    for (int s = (64 / N) >> 1; s >= 1; s >>= 1) r += __shfl_xor(r, s);
    return r;
}

template <int MODE>
__device__ __forceinline__ void row_pass(const Args& a, LAS unsigned char* lds, const int vcu, const int G, const int wave, const int lane, const int tid) {
    constexpr int E = (MODE == 2) ? 32 : 16;
    constexpr bool COMBINE = (MODE == 2 || MODE == 4), PROJ = (MODE != 4), TWO = (MODE == 2);
    constexpr int LAYER = (MODE == 3 || MODE == 4) ? 1 : 0;
    unsigned char* ws = a.ws;
    LAS float* Wsm = (LAS float*)lds;
    LAS float* VA = (LAS float*)(lds + 131072);
    LAS float* VB = VA + 1024; LAS float* VA2 = VA + 2048; LAS float* VB2 = VA + 3072; LAS float* VG = VA + 4096;
    LAS float* RS = (LAS float*)(lds + 131072 + 20480);
    LAS int* LCNT = (LAS int*)(lds + 131072 + 20480 + 4096);
    LAS int* RREC = (LAS int*)(lds + 131072 + 20480 + 4096 + 256);
    LAS float* RW = (LAS float*)(lds + 131072 + 20480 + 4096 + 256 + 1024);
    if constexpr (PROJ) {
        const float* Wsrc; int ldw;
        if constexpr (MODE == 0) { Wsrc = (const float*)a.in[I_A_W_IN] + 3072; ldw = 3088; }
        else if constexpr (MODE == 2) { Wsrc = (const float*)a.in[I_KV_W_DOWN] + 256; ldw = 288; }
        else { Wsrc = (const float*)a.in[I_ROUTER_W]; ldw = 16; }
        for (int idx = tid; idx < 1024 * E; idx += NTHR) { const int k = idx / E, e = idx % E; const float v = Wsrc[(size_t)k * ldw + e];
            const int lk = (k >> 2) & 63, ridx = ((k >> 8) * 4 + (k & 3)) * 64 + lk; const int sw = (E == 16) ? ((lk >> 2) & 3) : ((lk >> 1) & 7);
            Wsm[ridx * E + (((e >> 2) ^ sw) << 2) + (e & 3)] = v; }
    }
    if constexpr (COMBINE) { if (tid == 0) { const int* cnt = (const int*)(ws + WS_CTL) + CW_CNT + LAYER * 16 * 64; int acc_ = 0;
            for (int e = 0; e < 16; ++e) { LCNT[e] = acc_; acc_ += (cnt[e * 64] + 255) >> 8; } } }
    for (int chunk = vcu; chunk < M / 64; chunk += G) {
        const int row0 = chunk * 64, b = row0 / SEQ;
        __syncthreads();
        for (int k = tid; k < 1024; k += NTHR) {
            if constexpr (MODE == 0) { VA[k] = ((const float*)a.in[I_A_NORM_G])[k] * (1.f + mod_value(a, b, 1024 + k)); VB[k] = mod_value(a, b, k); }
            if constexpr (MODE == 1 || MODE == 3) { VA[k] = ((const float*)a.in[I_FFN_NORM_G])[LAYER * 1024 + k] * (1.f + mod_value(a, b, LAYER * 6144 + 4096 + k)); VB[k] = mod_value(a, b, LAYER * 6144 + 3072 + k); }
            if constexpr (MODE == 2) { VA[k] = ((const float*)a.in[I_KV_NORM_G])[k] * (1.f + mod_value(a, b, 12288 + 1024 + k)); VB[k] = mod_value(a, b, 12288 + k);
                                       VA2[k] = ((const float*)a.in[I_B_NORM_G])[k] * (1.f + mod_value(a, b, 6144 + 1024 + k)); VB2[k] = mod_value(a, b, 6144 + k); }
            if constexpr (MODE == 4) { VA[k] = ((const float*)a.in[I_FINAL_NORM_G])[k]; }
            if constexpr (COMBINE) VG[k] = mod_value(a, b, LAYER * 6144 + 5120 + k);
        }
        if constexpr (MODE == 1 || MODE == 3) { if (tid < 32) LCNT[tid] = 0; }
        __syncthreads();
#pragma unroll 1
        for (int rr = 0; rr < 8; rr += 1) {
            float hx[1][16]; float pacc[1][E];
#pragma unroll
            for (int q = 0; q < 1; ++q) {
                const int lr = wave * 8 + rr + q, row = row0 + lr;
                f32x4 x[4];
                if constexpr (MODE == 0) { const f32x4* xr = (const f32x4*)((const float*)a.in[I_X] + (size_t)row * D) + lane;
#pragma unroll
                    for (int j = 0; j < 4; ++j) x[j] = xr[64 * j]; }
                else { const f32x4* xr = (const f32x4*)((const float*)(ws + WS_XR) + (size_t)row * D) + lane;
#pragma unroll
                    for (int j = 0; j < 4; ++j) x[j] = xr[64 * j]; }
                if constexpr (COMBINE) {
                    const int4 rt = ((const int4*)(ws + WS_ROUTE))[row];
                    const int base0 = LCNT[rt.x], base1 = LCNT[rt.z];
                    const u32x2* y0 = (const u32x2*)((const bf16*)(ws + WS_Y) + (size_t)(base0 * 256 + rt.y) * D) + lane;
                    const u32x2* y1 = (const u32x2*)((const bf16*)(ws + WS_Y) + (size_t)(base1 * 256 + rt.w) * D) + lane;
#pragma unroll
                    for (int j = 0; j < 4; ++j) { const u32x2 p = y0[64 * j], r2 = y1[64 * j]; const f32x4 g = *(const LAS f32x4*)(VG + 256 * j + 4 * lane);
                        x[j][0] += g[0] * (bflo(p.x) + bflo(r2.x)); x[j][1] += g[1] * (bfhi(p.x) + bfhi(r2.x)); x[j][2] += g[2] * (bflo(p.y) + bflo(r2.y)); x[j][3] += g[3] * (bfhi(p.y) + bfhi(r2.y)); }
                    if constexpr (MODE == 2) { f32x4* xw = (f32x4*)((float*)(ws + WS_XR) + (size_t)row * D) + lane;
#pragma unroll
                        for (int j = 0; j < 4; ++j) xw[64 * j] = x[j]; }
                }
                float ss = 0.f;
#pragma unroll
                for (int j = 0; j < 4; ++j) ss += (x[j][0] * x[j][0] + x[j][1] * x[j][1]) + (x[j][2] * x[j][2] + x[j][3] * x[j][3]);
                const float rstd = rsqrtf(wave_sum(ss) * (1.f / D) + EPS);
                if constexpr (MODE == 4) {
                    f32x4* ow = (f32x4*)(a.out + (size_t)row * D) + lane;
#pragma unroll
                    for (int j = 0; j < 4; ++j) { const f32x4 g = *(const LAS f32x4*)(VA + 256 * j + 4 * lane); ow[64 * j] = x[j] * rstd * g; }
                } else {
                    bf16* Hout = (bf16*)(ws + WS_H);
                    u32x2* hw = (u32x2*)(Hout + (size_t)row * D) + lane;
#pragma unroll
                    for (int j = 0; j < 4; ++j) { const f32x4 A = *(const LAS f32x4*)(VA + 256 * j + 4 * lane), Bv = *(const LAS f32x4*)(VB + 256 * j + 4 * lane);
                        const f32x4 hv = x[j] * rstd * A + Bv; hx[q][4 * j] = hv[0]; hx[q][4 * j + 1] = hv[1]; hx[q][4 * j + 2] = hv[2]; hx[q][4 * j + 3] = hv[3];
                        u32x2 w; w.x = cvt_pk_bf16(hv[0], hv[1]); w.y = cvt_pk_bf16(hv[2], hv[3]); hw[64 * j] = w; }
                    if constexpr (TWO) { u32x2* hw2 = (u32x2*)((bf16*)(ws + WS_H1) + (size_t)row * D) + lane;
#pragma unroll
                        for (int j = 0; j < 4; ++j) { const f32x4 A = *(const LAS f32x4*)(VA2 + 256 * j + 4 * lane), Bv = *(const LAS f32x4*)(VB2 + 256 * j + 4 * lane);
                            const f32x4 hv = x[j] * rstd * A + Bv; u32x2 w; w.x = cvt_pk_bf16(hv[0], hv[1]); w.y = cvt_pk_bf16(hv[2], hv[3]); hw2[64 * j] = w; } }
                }
            }
            if constexpr (PROJ) {
#pragma unroll
                for (int q = 0; q < 1; ++q)
#pragma unroll
                    for (int e = 0; e < E; ++e) pacc[q][e] = 0.f;
                const int sw = (E == 16) ? ((lane >> 2) & 3) : ((lane >> 1) & 7);
#pragma unroll
                for (int ji = 0; ji < 16; ++ji) {
                    const LAS float* wrow = Wsm + (ji * 64 + lane) * E;
#pragma unroll
                    for (int c = 0; c < E / 4; ++c) { const f32x4 w4 = *(const LAS f32x4*)(wrow + ((c ^ sw) << 2));
#pragma unroll
                        for (int q = 0; q < 1; ++q) { const float hv = hx[q][ji]; pacc[q][4 * c] += hv * w4[0]; pacc[q][4 * c + 1] += hv * w4[1]; pacc[q][4 * c + 2] += hv * w4[2]; pacc[q][4 * c + 3] += hv * w4[3]; } }
                    asm volatile("" ::: "memory");
                }
#pragma unroll
                for (int q = 0; q < 1; ++q) {
                    const int lr = wave * 8 + rr + q, row = row0 + lr;
                    const float v = wave_reduce_multi<E>(pacc[q], lane);
                    if constexpr (MODE == 0) { const int e = (lane >> 2) & 15; const float z = v + ((const float*)a.in[I_A_B_F])[e];
                        const float lf = z < 0.f ? z - log1pf(__expf(z)) : -log1pf(__expf(-z));
                        if ((lane & 3) == 0) ((float*)(ws + WS_LF))[(size_t)row * 16 + e] = lf; }
                    if constexpr (MODE == 1 || MODE == 3) { const int e = (lane >> 2) & 15; if ((lane & 3) == 0) RS[lr * 16 + e] = v; }
                    if constexpr (MODE == 2) { const int e = (lane >> 1) & 31, i = e & 15; const float partner = __shfl_xor(v, 32);
                        const f32x2 cs = ((const f32x2*)(ws + WS_ROPE))[(size_t)row * 16 + i];
                        const float o = (e < 16) ? v * cs[0] - partner * cs[1] : v * cs[0] + partner * cs[1];
                        if ((lane & 1) == 0) ((bf16*)(ws + WS_KR))[(size_t)row * 32 + 2 * i + (e >> 4)] = (bf16)(cvt_pk_bf16(o, 0.f) & 0xffffu); }
                }
            }
        }
        if constexpr (MODE == 1 || MODE == 3) {
            asm volatile("s_waitcnt lgkmcnt(0)" ::: "memory");
            if (lane < 8) {
                const int lr = wave * 8 + lane; const float* rb = (const float*)a.in[I_ROUTER_BIAS];
                float sc[16], sel[16];
#pragma unroll
                for (int e = 0; e < 16; ++e) { const float z = RS[lr * 16 + e]; sc[e] = 1.f / (1.f + expf(-z)); sel[e] = sc[e] + rb[e]; }
                int gbest = 0; float gs_best = -INFINITY;
#pragma unroll
                for (int g = 0; g < 4; ++g) { float m1 = -INFINITY, m2 = -INFINITY;
#pragma unroll
                    for (int j = 0; j < 4; ++j) { const float s = sel[4 * g + j]; if (s > m1) { m2 = m1; m1 = s; } else if (s > m2) m2 = s; }
                    const float gsum = m1 + m2; if (gsum > gs_best) { gs_best = gsum; gbest = g; } }
                float s4[4], c4[4];
#pragma unroll
                for (int j = 0; j < 4; ++j) { float sv = 0.f, cv = 0.f;
#pragma unroll
                    for (int g = 0; g < 4; ++g) if (g == gbest) { sv = sel[4 * g + j]; cv = sc[4 * g + j]; }
                    s4[j] = sv; c4[j] = cv; }
                int i0 = 0;
#pragma unroll
                for (int j = 1; j < 4; ++j) if (s4[j] > s4[i0]) i0 = j;
                int i1 = (i0 == 0) ? 1 : 0;
#pragma unroll
                for (int j = 0; j < 4; ++j) if (j != i0 && j != i1 && s4[j] > s4[i1]) i1 = j;
                float w0 = 0.f, w1 = 0.f;
#pragma unroll
                for (int j = 0; j < 4; ++j) { if (j == i0) w0 = c4[j]; if (j == i1) w1 = c4[j]; }
                const float inv = 1.f / (w0 + w1);
                const int e0 = gbest * 4 + i0, e1 = gbest * 4 + i1;
                const int lp0 = __hip_atomic_fetch_add(LCNT + e0, 1, __ATOMIC_RELAXED, __HIP_MEMORY_SCOPE_WORKGROUP);
                const int lp1 = __hip_atomic_fetch_add(LCNT + e1, 1, __ATOMIC_RELAXED, __HIP_MEMORY_SCOPE_WORKGROUP);
                RREC[lr * 4 + 0] = e0; RREC[lr * 4 + 1] = lp0; RREC[lr * 4 + 2] = e1; RREC[lr * 4 + 3] = lp1; RW[lr * 2] = w0 * inv; RW[lr * 2 + 1] = w1 * inv;
            }
            __syncthreads();
            if (tid < 16) { int* cnt = (int*)(ws + WS_CTL) + CW_CNT + LAYER * 16 * 64; const int n = LCNT[tid];
                LCNT[16 + tid] = n ? __hip_atomic_fetch_add(cnt + tid * 64, n, RLX_AGENT) : 0; }
            __syncthreads();
            if (tid < 64) { const int row = row0 + tid; const int e0 = RREC[tid * 4], e1 = RREC[tid * 4 + 2]; const int p0 = LCNT[16 + e0] + RREC[tid * 4 + 1], p1 = LCNT[16 + e1] + RREC[tid * 4 + 3];
                int* list = (int*)(ws + WS_LIST); float* wl = (float*)(ws + WS_WLIST);
                list[(size_t)e0 * M + p0] = row; list[(size_t)e1 * M + p1] = row; wl[(size_t)e0 * M + p0] = RW[tid * 2]; wl[(size_t)e1 * M + p1] = RW[tid * 2 + 1];
                ((int4*)(ws + WS_ROUTE))[row] = make_int4(e0, p0, e1, p1); }
        }
    }
    __syncthreads();
}

namespace epi {
using pg8::Unit; using pg8::BM; using pg8::HALF;
__device__ __forceinline__ int opaque(int x) { asm volatile("" : "+v"(x)); return x; }
struct Bf16Split {
    static constexpr bool PERM = true;
    bf16* O; int ldc; int split_tiles; size_t split_stride; float scale0;
    __device__ __forceinline__ void operator()(const f32x4 (&acc)[2][2][4][2], const Unit& u, int wr, int wc, int fr, int fq) const {
        int pn = u.pn; bf16* base = O; float sc = 1.f;
        if (split_tiles) { const int t = pn / split_tiles; base += (size_t)t * split_stride; pn -= t * split_tiles; if (t == 0) sc = scale0; }
        const int row0 = u.pm * BM + opaque(wr * 64 + fr), col0 = pn * BM + wc * 32 + 8 * fq;
#pragma unroll
        for (int ai = 0; ai < 2; ++ai)
#pragma unroll
            for (int m = 0; m < 4; ++m) { bf16* rowp = base + (size_t)(row0 + ai * HALF + m * 16) * ldc + col0;
#pragma unroll
                for (int bj = 0; bj < 2; ++bj) { const f32x4 v0 = acc[ai][bj][m][0] * sc, v1 = acc[ai][bj][m][1] * sc;
                    u32x4 w; w.x = cvt_pk_bf16(v0[0], v0[1]); w.y = cvt_pk_bf16(v0[2], v0[3]); w.z = cvt_pk_bf16(v1[0], v1[1]); w.w = cvt_pk_bf16(v1[2], v1[3]);
                    *(u32x4*)(rowp + bj * HALF) = w; } }
    }
};
struct Resid {
    static constexpr bool PERM = false;
    const float* base; float* out; const float* gate;
    __device__ __forceinline__ void operator()(const f32x4 (&acc)[2][2][4][2], const Unit& u, int wr, int wc, int fr, int fq) const {
        const int b = (u.pm * BM) / SEQ; const int col0 = u.pn * BM + wc * 32 + 4 * fq; const int rb = opaque(wr * 64 + fr);
        f32x4 gv[2][2];
#pragma unroll
        for (int bj = 0; bj < 2; ++bj)
#pragma unroll
            for (int n = 0; n < 2; ++n) gv[bj][n] = *(const f32x4*)(gate + (size_t)b * MODN + col0 + bj * HALF + n * 16);
#pragma unroll
        for (int ai = 0; ai < 2; ++ai)
#pragma unroll
            for (int m = 0; m < 4; ++m) { const size_t off = (size_t)(u.pm * BM + ai * HALF + m * 16 + rb) * D + col0;
#pragma unroll
                for (int bj = 0; bj < 2; ++bj)
#pragma unroll
                    for (int n = 0; n < 2; ++n) { const f32x4 bs = *(const f32x4*)(base + off + bj * HALF + n * 16); *(f32x4*)(out + off + bj * HALF + n * 16) = bs + gv[bj][n] * acc[ai][bj][m][n]; } }
    }
};
struct GateUp {
    static constexpr bool PERM = true;
    bf16* act;
    __device__ __forceinline__ void operator()(const f32x4 (&acc)[2][2][4][2], const Unit& u, int wr, int wc, int fr, int fq) const {
        const int col0 = u.pn * 128 + wc * 32 + 8 * fq; const int rb = opaque(wr * 64 + fr);
#pragma unroll
        for (int ai = 0; ai < 2; ++ai)
#pragma unroll
            for (int m = 0; m < 4; ++m) { const size_t srow = (size_t)u.pm * BM + ai * HALF + m * 16 + rb; float r[8];
#pragma unroll
                for (int n = 0; n < 2; ++n)
#pragma unroll
                    for (int i = 0; i < 4; ++i) { const float g = acc[ai][0][m][n][i], up = acc[ai][1][m][n][i]; r[4 * n + i] = g * __builtin_amdgcn_rcpf(1.f + __builtin_amdgcn_exp2f(-g * LOG2E)) * up; }
                u32x4 w; w.x = cvt_pk_bf16(r[0], r[1]); w.y = cvt_pk_bf16(r[2], r[3]); w.z = cvt_pk_bf16(r[4], r[5]); w.w = cvt_pk_bf16(r[6], r[7]);
                *(u32x4*)(act + srow * DEXP + col0) = w; }
    }
};
struct Down {
    static constexpr bool PERM = true;
    bf16* Y; const float* wlist; const LAS int* tb; const LAS int* cn;
    __device__ __forceinline__ void operator()(const f32x4 (&acc)[2][2][4][2], const Unit& u, int wr, int wc, int fr, int fq) const {
        const int e = u.aux, mt = u.pm - tb[e], cnt = cn[e]; const int col0 = u.pn * BM + wc * 32 + 8 * fq; const int rb = opaque(wr * 64 + fr);
#pragma unroll
        for (int ai = 0; ai < 2; ++ai)
#pragma unroll
            for (int m = 0; m < 4; ++m) { const int lr = ai * HALF + m * 16 + rb, li = mt * BM + lr; const float w = li < cnt ? wlist[(size_t)e * M + li] : 0.f;
                bf16* rowp = Y + ((size_t)u.pm * BM + lr) * D + col0;
#pragma unroll
                for (int bj = 0; bj < 2; ++bj) { const f32x4 v0 = acc[ai][bj][m][0] * w, v1 = acc[ai][bj][m][1] * w;
                    u32x4 x; x.x = cvt_pk_bf16(v0[0], v0[1]); x.y = cvt_pk_bf16(v0[2], v0[3]); x.z = cvt_pk_bf16(v1[0], v1[1]); x.w = cvt_pk_bf16(v1[2], v1[3]);
                    *(u32x4*)(rowp + bj * HALF) = x; }
                asm volatile("" ::: "memory"); }
    }
};
struct LowRank {
    static constexpr bool PERM = true;
    bf16* O0; float* SS0; bf16* O1; float* SS1;
    __device__ __forceinline__ void operator()(const f32x4 (&acc)[2][2][4][2], const Unit& u, int wr, int wc, int fr, int fq) const {
        bf16* O = u.aux ? O1 : O0; float* SS = u.aux ? SS1 : SS0; const int ldc = u.aux ? QRANK : KVRANK;
        const int col0 = u.pn * BM + wc * 32 + 8 * fq; const int rb = opaque(wr * 64 + fr);
#pragma unroll
        for (int ai = 0; ai < 2; ++ai)
#pragma unroll
            for (int m = 0; m < 4; ++m) { const int row = u.pm * BM + ai * HALF + m * 16 + rb; float s = 0.f;
#pragma unroll
                for (int bj = 0; bj < 2; ++bj) { const f32x4 v0 = acc[ai][bj][m][0], v1 = acc[ai][bj][m][1];
                    s += (v0[0] * v0[0] + v0[1] * v0[1]) + (v0[2] * v0[2] + v0[3] * v0[3]) + (v1[0] * v1[0] + v1[1] * v1[1]) + (v1[2] * v1[2] + v1[3] * v1[3]);
                    u32x4 x; x.x = cvt_pk_bf16(v0[0], v0[1]); x.y = cvt_pk_bf16(v0[2], v0[3]); x.z = cvt_pk_bf16(v1[0], v1[1]); x.w = cvt_pk_bf16(v1[2], v1[3]);
                    *(u32x4*)(O + (size_t)row * ldc + col0 + bj * HALF) = x; }
                s += __shfl_xor(s, 16); s += __shfl_xor(s, 32);
                if (fq == 0) atomicAdd(SS + row, s);
                asm volatile("" ::: "memory"); }
    }
};
struct KvUp {
    static constexpr bool PERM = true;
    bf16* KN; bf16* V; const float* SS;
    __device__ __forceinline__ void operator()(const f32x4 (&acc)[2][2][4][2], const Unit& u, int wr, int wc, int fr, int fq) const {
        bf16* base = u.pn < 4 ? KN : V; const int col0 = (u.pn & 3) * BM + wc * 32 + 8 * fq; const int rb = opaque(wr * 64 + fr);
#pragma unroll
        for (int ai = 0; ai < 2; ++ai)
#pragma unroll
            for (int m = 0; m < 4; ++m) { const int row = u.pm * BM + ai * HALF + m * 16 + rb; const float rs = rsqrtf(SS[row] * (1.f / KVRANK) + EPS);
#pragma unroll
                for (int bj = 0; bj < 2; ++bj) { const f32x4 v0 = acc[ai][bj][m][0] * rs, v1 = acc[ai][bj][m][1] * rs;
                    u32x4 x; x.x = cvt_pk_bf16(v0[0], v0[1]); x.y = cvt_pk_bf16(v0[2], v0[3]); x.z = cvt_pk_bf16(v1[0], v1[1]); x.w = cvt_pk_bf16(v1[2], v1[3]);
                    *(u32x4*)(base + (size_t)row * D + col0 + bj * HALF) = x; }
                asm volatile("" ::: "memory"); }
    }
};
struct QUp {
    static constexpr bool PERM = true;
    bf16* Q; const float* SS; const f32x2* tab;
    __device__ __forceinline__ void operator()(const f32x4 (&acc)[2][2][4][2], const Unit& u, int wr, int wc, int fr, int fq) const {
        const int rb = opaque(wr * 64 + fr); const int cb = opaque(wc * 32 + 8 * fq);
#pragma unroll
        for (int ai = 0; ai < 2; ++ai)
#pragma unroll
            for (int m = 0; m < 4; ++m) { const int row = u.pm * BM + ai * HALF + m * 16 + rb; const float rs = rsqrtf(SS[row] * (1.f / QRANK) + EPS) * C2_MLA;
#pragma unroll
                for (int bj = 0; bj < 2; ++bj) { const int col0 = u.pn * BM + bj * HALF + cb; const int hq = col0 / 96, jj = col0 - hq * 96;
                    float v[8];
#pragma unroll
                    for (int n = 0; n < 2; ++n)
#pragma unroll
                        for (int i = 0; i < 4; ++i) v[4 * n + i] = acc[ai][bj][m][n][i] * rs;
                    if (jj >= 64) { const f32x4* tp = (const f32x4*)(tab + (size_t)row * 16 + ((jj - 64) >> 1)); const f32x4 t0 = tp[0], t1 = tp[1];
                        const float cs[4] = {t0[0], t0[2], t1[0], t1[2]}, sn[4] = {t0[1], t0[3], t1[1], t1[3]};
#pragma unroll
                        for (int p = 0; p < 4; ++p) { const float x1 = v[2 * p], x2 = v[2 * p + 1]; v[2 * p] = x1 * cs[p] - x2 * sn[p]; v[2 * p + 1] = x2 * cs[p] + x1 * sn[p]; } }
                    u32x4 x; x.x = cvt_pk_bf16(v[0], v[1]); x.y = cvt_pk_bf16(v[2], v[3]); x.z = cvt_pk_bf16(v[4], v[5]); x.w = cvt_pk_bf16(v[6], v[7]);
                    *(u32x4*)(Q + (size_t)row * QCAT + col0) = x; }
                asm volatile("" ::: "memory"); }
    }
};
}

template <bool GATHER> struct MoeOrder {
    static constexpr bool EARLY_AOFF = true;
    const LAS int* tb; const LAS int* cn; int G, c, nN; int K;
    const char* A; const char* Bt; size_t b_expert_bytes; const int* list;
    __device__ __forceinline__ bool next(int i, pg8::Unit& u) const {
        const long L = (long)i * G + c; const int total = tb[16] * nN; if (L >= total) return false;
        const int mg = (int)(L / nN), pn = (int)(L % nN); int e = 0;
#pragma unroll
        for (int x = 1; x < 16; ++x) if (mg >= tb[x]) e = x;
        u.pm = mg; u.pn = pn; u.aux = e; u.A = A; u.B = Bt + (size_t)e * b_expert_bytes + (size_t)pn * 256 * K * 2; return true;
    }
    __device__ __forceinline__ unsigned a_off(const pg8::Unit& u, int r, int cc) const {
        if constexpr (GATHER) { const int e = u.aux, li = (u.pm - tb[e]) * 256 + r; const int tok = li < cn[e] ? list[(size_t)e * M + li] : 0; return (unsigned)(tok * K + cc) * 2u; }
        return (unsigned)((u.pm * 256 + r) * K + cc) * 2u;
    }
};
struct LowRankOrder {
    static constexpr bool EARLY_AOFF = true;
    const char* A0; const char* B0; const char* A1; const char* B1; int G, c;
    __device__ __forceinline__ bool next(int i, pg8::Unit& u) const {
        const int L = i * G + c; if (L >= 256) return false;
        const int x = L & 7, j = L >> 3, sub = j & 3; u.pm = 8 * x + (j >> 2);
        if (sub == 0) { u.pn = 0; u.aux = 0; u.A = A0; u.B = B0; } else { u.pn = sub - 1; u.aux = 1; u.A = A1; u.B = B1 + (size_t)(sub - 1) * 256 * 1024 * 2; }
        return true;
    }
    __device__ __forceinline__ unsigned a_off(const pg8::Unit& u, int r, int cc) const { return (unsigned)((u.pm * 256 + r) * 1024 + cc) * 2u; }
};

constexpr int NPHASE = 17;
__global__ void __launch_bounds__(NTHR, 2) fwd_kernel(Args args) {
    extern __shared__ __attribute__((aligned(16))) unsigned char lds_raw[];
    LAS unsigned char* lds = (LAS unsigned char*)lds_raw;
    volatile LAS unsigned* MISC = (volatile LAS unsigned*)(lds + LDS_MISC);
#define PH_IDS int tid = threadIdx.x; asm volatile("" : "+v"(tid)); const int lane = tid & 63, wave = __builtin_amdgcn_readfirstlane(tid >> 6); const int gw = vcu * NWAVES + wave; (void)lane; (void)gw;
    const int G = gridDim.x; const int bx = blockIdx.x; const int vcu = (G % 8 == 0) ? (bx % 8) * (G / 8) + bx / 8 : bx;
    unsigned char* ws = args.ws;
    gu32* ctl = (gu32*)(ws + WS_CTL);
    for (int u = threadIdx.x; u < 256; u += NTHR) ((LAS unsigned*)(lds + LDS_MISC))[u] = 0u;
    __syncthreads();
    XcdBarrier bar = xcd_barrier_post((unsigned*)ctl + CW_BAR, MISC);
    const int lo = args.ph_lo, hi = args.ph_hi;
#ifndef PH_MASK
#define PH_MASK 0x1ffff
#endif
#define IN(k) (((PH_MASK >> (k)) & 1) && lo <= (k) && (k) < hi)
#define SEAM(k) do { if (IN(k) && IN((k) + 1)) xcd_barrier(bar); } while (0)
    const int NGW = G * NWAVES;
    const LAS int* TB = (const LAS int*)(lds + LDS_MISC + 64);
    const LAS int* CN = (const LAS int*)(lds + LDS_MISC + 192);
#define MOE_TABLES(L) do { __syncthreads(); if (threadIdx.x == 0) { const int* cnt = (const int*)(ws + WS_CTL) + CW_CNT + (L) * 16 * 64; int acc_ = 0; \
        LAS int* tbw = (LAS int*)(lds + LDS_MISC + 64); LAS int* cnw = (LAS int*)(lds + LDS_MISC + 192); \
        for (int e_ = 0; e_ < 16; ++e_) { const int c_ = cnt[e_ * 64]; tbw[e_] = acc_; cnw[e_] = c_; acc_ += (c_ + 255) >> 8; } tbw[16] = acc_; } __syncthreads(); } while (0)

    if (IN(0)) { PH_IDS p0_prologue(args, lds, gw, NGW, wave, lane, tid); }
    SEAM(0);
    if (IN(1)) { PH_IDS
        for (int idx = bx * NTHR + tid; idx < 8 * MODN; idx += G * NTHR) ((float*)(ws + WS_MODF))[idx] = mod_value(args, idx / MODN, idx % MODN);
        row_pass<0>(args, lds, vcu, G, wave, lane, tid);
    }
    SEAM(1);
    if (IN(2)) { PH_IDS
        for (int task = gw; task < BATCH * NH; task += NGW) { const int b = task / NH, h = task % NH;
            const float* lf = (const float*)(ws + WS_LF) + ((size_t)b * SEQ + 32 * lane) * 16 + h; float v[32]; float run = 0.f;
#pragma unroll
            for (int i = 0; i < 32; ++i) { run += lf[(size_t)i * 16]; v[i] = run; }
            float incl = run;
#pragma unroll
            for (int o = 1; o < 64; o <<= 1) { const float t = __shfl_up(incl, o); if (lane >= o) incl += t; }
            const float excl = incl - run;
            u32x4* kb = (u32x4*)(ws + WS_KB) + ((size_t)b * SEQ + 32 * lane) * 16 + h;
#pragma unroll
            for (int i = 0; i < 32; ++i) { const float bias = -(v[i] + excl) * LOG2E; const unsigned b1 = cvt_pk_bf16(bias, 0.f) & 0xffffu; const float r1 = bias - __uint_as_float(b1 << 16);
                const unsigned b2 = cvt_pk_bf16(r1, 0.f) & 0xffffu; const float r2 = r1 - __uint_as_float(b2 << 16); const unsigned b3 = cvt_pk_bf16(r2, 0.f) & 0xffffu;
                kb[(size_t)i * 16] = (u32x4){b1 | (b2 << 16), b3, 0u, 0u}; }
        }
        pg8::StaticOrder S; S.init(ws + WS_H, ws + WS_WIN, M, 3072, 1024, G, bx);
        epi::Bf16Split E{(bf16*)(ws + WS_Q), D, 4, (size_t)16 * MiB, C2_FOX};
        pg8::gemm_phase<epi::Bf16Split, pg8::StaticOrder, true>(lds, 1024, S, E);
    }
    SEAM(2);
    if (IN(3)) {
        const attn::Args T{(const bf16*)(ws + WS_Q), D, 64, (const bf16*)(ws + WS_K), (const char*)(ws + WS_KB), 256, 16, (const bf16*)(ws + WS_V), (bf16*)(ws + WS_Q)};
        attn::attn_phase<0>((LAS char*)lds, T, vcu, G);
    }
    SEAM(3);
    if (IN(4)) {
        pg8::StaticOrder S; S.init(ws + WS_Q, ws + WS_WO0, M, 1024, 1024, G, bx);
        epi::Resid E{(const float*)args.in[I_X], (float*)(ws + WS_XR), (const float*)(ws + WS_MODF) + 2048};
        pg8::gemm_phase<epi::Resid, pg8::StaticOrder, false>(lds, 1024, S, E);
    }
    SEAM(4);
    if (IN(5)) { PH_IDS row_pass<1>(args, lds, vcu, G, wave, lane, tid); }
    SEAM(5);
    if (IN(6)) {
        MOE_TABLES(0);
        MoeOrder<true> S{TB, CN, G, bx, 4, 1024, (const char*)(ws + WS_H), (const char*)(ws + WS_EW), (size_t)1024 * 1024 * 2, (const int*)(ws + WS_LIST)};
        epi::GateUp E{(bf16*)(ws + WS_ACT)};
        pg8::gemm_phase<epi::GateUp, MoeOrder<true>, true>(lds, 1024, S, E);
    }
    SEAM(6);
    if (IN(7)) {
        MOE_TABLES(0);
        MoeOrder<false> S{TB, CN, G, bx, 4, 512, (const char*)(ws + WS_ACT), (const char*)(ws + WS_EW + EW_D), (size_t)1024 * 512 * 2, nullptr};
        epi::Down E{(bf16*)(ws + WS_Y), (const float*)(ws + WS_WLIST), TB, CN};
        pg8::gemm_phase<epi::Down, MoeOrder<false>, true>(lds, 512, S, E);
    }
    SEAM(7);
    if (IN(8)) { PH_IDS row_pass<2>(args, lds, vcu, G, wave, lane, tid); }
    SEAM(8);
    if (IN(9)) {
        LowRankOrder S{(const char*)(ws + WS_HKV), (const char*)(ws + WS_WDN), (const char*)(ws + WS_H1), (const char*)(ws + WS_WDQ), G, bx};
        epi::LowRank E{(bf16*)(ws + WS_CKV), (float*)(ws + WS_SSKV), (bf16*)(ws + WS_CQ), (float*)(ws + WS_SSQ)};
        pg8::gemm_phase<epi::LowRank, LowRankOrder, false>(lds, 1024, S, E);
    }
    SEAM(9);
    if (IN(10)) {
        { pg8::StaticOrder S; S.init(ws + WS_CKV, ws + WS_WUP, M, 2048, 256, G, bx);
          epi::KvUp E{(bf16*)(ws + WS_KN), (bf16*)(ws + WS_V2), (const float*)(ws + WS_SSKV)};
          pg8::gemm_phase<epi::KvUp, pg8::StaticOrder, true>(lds, 256, S, E); }
        { pg8::StaticOrder S; S.init(ws + WS_CQ, ws + WS_WUQ, M, 1536, 768, G, bx);
          epi::QUp E{(bf16*)(ws + WS_QCAT), (const float*)(ws + WS_SSQ), (const f32x2*)(ws + WS_ROPE)};
          pg8::gemm_phase<epi::QUp, pg8::StaticOrder, true>(lds, 768, S, E); }
    }
    SEAM(10);
    if (IN(11)) {
        const attn::Args T{(const bf16*)(ws + WS_QCAT), QCAT, 96, (const bf16*)(ws + WS_KN), (const char*)(ws + WS_KR), 64, 0, (const bf16*)(ws + WS_V2), (bf16*)(ws + WS_O2)};
        attn::attn_phase<1>((LAS char*)lds, T, vcu, G);
    }
    SEAM(11);
    if (IN(12)) {
        pg8::StaticOrder S; S.init(ws + WS_O2, ws + WS_WO1, M, 1024, 1024, G, bx);
        epi::Resid E{(const float*)(ws + WS_XR), (float*)(ws + WS_XR), (const float*)(ws + WS_MODF) + 6144 + 2048};
        pg8::gemm_phase<epi::Resid, pg8::StaticOrder, false>(lds, 1024, S, E);
    }
    SEAM(12);
    if (IN(13)) { PH_IDS row_pass<3>(args, lds, vcu, G, wave, lane, tid); }
    SEAM(13);
    if (IN(14)) {
        MOE_TABLES(1);
        MoeOrder<true> S{TB, CN, G, bx, 4, 1024, (const char*)(ws + WS_H), (const char*)(ws + WS_EW + EW_LAYER), (size_t)1024 * 1024 * 2, (const int*)(ws + WS_LIST)};
        epi::GateUp E{(bf16*)(ws + WS_ACT)};
        pg8::gemm_phase<epi::GateUp, MoeOrder<true>, true>(lds, 1024, S, E);
    }
    SEAM(14);
    if (IN(15)) {
        MOE_TABLES(1);
        MoeOrder<false> S{TB, CN, G, bx, 4, 512, (const char*)(ws + WS_ACT), (const char*)(ws + WS_EW + EW_LAYER + EW_D), (size_t)1024 * 512 * 2, nullptr};
        epi::Down E{(bf16*)(ws + WS_Y), (const float*)(ws + WS_WLIST), TB, CN};
        pg8::gemm_phase<epi::Down, MoeOrder<false>, true>(lds, 512, S, E);
    }
    SEAM(15);
    if (IN(16)) { PH_IDS row_pass<4>(args, lds, vcu, G, wave, lane, tid); }
#undef IN
#undef PH_IDS
#undef SEAM
#undef MOE_TABLES
}

#ifndef MK_CUTS
#define MK_CUTS 0
#endif
extern "C" void kernel_launch(void* const* d_in, const int* in_sizes, int n_in, void* d_out, int out_size, void* d_ws, size_t ws_size, hipStream_t stream) {
    static int grid = 0;
    if (grid == 0) {
        if (n_in != 27 || in_sizes[0] != M * D || out_size != M * D || ws_size < WS_END) { fprintf(stderr, "kernel_launch: unexpected shapes (n_in %d, in0 %d, out %d, ws %zu need %zu); nothing launched\n", n_in, n_in > 0 ? in_sizes[0] : -1, out_size, ws_size, (size_t)WS_END); grid = -1; return; }
        int dev = 0, cus = 0, per_cu = 0;
        if (hipGetDevice(&dev) != hipSuccess || hipDeviceGetAttribute(&cus, hipDeviceAttributeMultiprocessorCount, dev) != hipSuccess) { grid = -1; return; }
        if (hipFuncSetAttribute((const void*)fwd_kernel, hipFuncAttributeMaxDynamicSharedMemorySize, LDS_BYTES) != hipSuccess) { fprintf(stderr, "kernel_launch: hipFuncSetAttribute failed\n"); grid = -1; return; }
        if (hipOccupancyMaxActiveBlocksPerMultiprocessor(&per_cu, (const void*)fwd_kernel, NTHR, LDS_BYTES) != hipSuccess || per_cu < 1) { fprintf(stderr, "kernel_launch: occupancy query says %d\n", per_cu); }
        (void)hipGetLastError();
        grid = cus;
    }
    if (grid < 0) return;
    if (hipMemsetAsync((char*)d_ws + WS_CTL, 0, CTL_ZERO_BYTES, stream) != hipSuccess) return;
    Args a{};
    for (int i = 0; i < 27; ++i) a.in[i] = d_in[i];
    a.out = (float*)d_out; a.ws = (unsigned char*)d_ws;
#if MK_CUTS
    for (int p = 0; p < NPHASE; ++p) { a.ph_lo = p; a.ph_hi = p + 1; hipLaunchKernelGGL(fwd_kernel, dim3(grid), dim3(NTHR), LDS_BYTES, stream, a); }
#else
    a.ph_lo = 0; a.ph_hi = NPHASE; hipLaunchKernelGGL(fwd_kernel, dim3(grid), dim3(NTHR), LDS_BYTES, stream, a);
#endif
}
```

```cpp
#define MK_CUTS 0
#include <hip/hip_runtime.h>
#include <cstdio>
#include <cstdint>

#define LAS __attribute__((address_space(3)))
#define GAS __attribute__((address_space(1)))
typedef unsigned short bf16;
typedef short bf16x8 __attribute__((ext_vector_type(8)));
typedef short s16x4 __attribute__((ext_vector_type(4)));
typedef float f32x2 __attribute__((ext_vector_type(2)));
typedef float f32x4 __attribute__((ext_vector_type(4)));
typedef float f32x16 __attribute__((ext_vector_type(16)));
typedef unsigned u32x2 __attribute__((ext_vector_type(2)));
typedef unsigned u32x4 __attribute__((ext_vector_type(4)));
typedef GAS unsigned gu32;

constexpr int BATCH = 8, SEQ = 2048, D = 1024, M = BATCH * SEQ, NH = 16;
constexpr int NEXP = 16, DEXP = 512;
constexpr int QRANK = 768, KVRANK = 256, QCAT = NH * 96;
constexpr float EPS = 1e-6f;
constexpr float LOG2E = 1.4426950408889634f;
constexpr float C2_FOX = 0.125f * LOG2E;
constexpr float C2_MLA = 0.10206207261596575f * LOG2E;
constexpr int MODN = 14336;
constexpr int NWAVES = 8, NTHR = 512;

__device__ __forceinline__ unsigned cvt_pk_bf16(float lo, float hi) { unsigned r; asm volatile("v_cvt_pk_bf16_f32 %0, %1, %2" : "=v"(r) : "v"(lo), "v"(hi)); return r; }
__device__ __forceinline__ float bf16_to_f(unsigned short b) { return __uint_as_float(((unsigned)b) << 16); }
__device__ __forceinline__ float bflo(unsigned w) { return __uint_as_float(w << 16); }
__device__ __forceinline__ float bfhi(unsigned w) { return __uint_as_float(w & 0xffff0000u); }

namespace pg8 {
constexpr int BM = 256, BK = 64, HALF = 128, HTB = HALF * BK * 2, STAGE_BYTES = 8 * HTB, NXCD = 8, WGM = 8;
__host__ __device__ __forceinline__ int lds_byte(int r, int c) { const int st = (r >> 4) * 2 + (c >> 5), rr = r & 15, cc = c & 31, ob = rr * 64 + cc * 2; return st * 1024 + (ob ^ (((ob >> 9) & 1) << 5)); }
__host__ __device__ __forceinline__ void stage_rc(int b, int& R, int& C) { const int st = b / 1024, sb = b % 1024, swz = sb ^ (((sb >> 9) & 1) << 5); R = (st >> 1) * 16 + swz / 64; C = (st & 1) * 32 + (swz % 64) / 2; }
__host__ __device__ __forceinline__ int perm32(int rho) { const int n = rho >> 4, i = rho & 15; return 8 * (i >> 2) + 4 * n + (i & 3); }

struct Unit { int pm, pn; const char* A; const char* B; int aux; };

template <class Epi, class Sched, bool ALIGN_EPI>
__device__ __forceinline__ void gemm_phase(LAS unsigned char* lds, const int K, const Sched& S, const Epi& E) {
    int tid_ = threadIdx.x; asm volatile("" : "+v"(tid_));
    const int tid = tid_, wid = __builtin_amdgcn_readfirstlane(tid >> 6), lane = tid & 63, wr = wid >> 2, wc = wid & 3, fr = lane & 15, fq = lane >> 4;
    const int nt = K / BK;
    unsigned voffB[2];
#pragma unroll
    for (int i = 0; i < 2; ++i) { int R, C; stage_rc(tid * 16 + i * 8192, R, C); const int Rb = Epi::PERM ? ((R & ~31) + perm32(R & 31)) : R;
        voffB[i] = (unsigned)(Rb * K + C) * 2u; }
#define PG8_AOFF(dst, unit) do { int t_ = threadIdx.x; asm volatile("" : "+v"(t_)); _Pragma("unroll") for (int i_ = 0; i_ < 2; ++i_) { int R_, C_; stage_rc(t_ * 16 + i_ * 8192, R_, C_); \
        _Pragma("unroll") for (int h_ = 0; h_ < 2; ++h_) dst[h_][i_] = S.a_off(unit, h_ * HALF + R_, C_); } } while (0)
    const size_t kstep = (size_t)(BK * 2);
    const size_t hstep = (size_t)HALF * K * 2;
    const unsigned ldsw = (unsigned)wid * 1024u;
    const int aoff = lds_byte(wr * 64 + fr, fq * 8), boff = lds_byte(wc * 32 + fr, fq * 8);
#define PG8_SA(b, h) (((b) * 2 + (h)) * HTB)
#define PG8_SB(b, h) ((4 + (b) * 2 + (h)) * HTB)
#define PG8_STAGE(bufoff, gbase, voff) do { _Pragma("unroll") for (int _i = 0; _i < 2; ++_i) { unsigned _vo = (voff)[_i]; asm volatile("" : "+v"(_vo));   \
        __builtin_amdgcn_global_load_lds((const unsigned*)((const char*)(gbase) + _vo), (LAS unsigned*)(lds + (bufoff) + ldsw + _i * 8192), 16, 0, 0); } } while (0)
#define PG8_LDA(dst, b, h) do { _Pragma("unroll") for (int m = 0; m < 4; ++m) _Pragma("unroll") for (int k = 0; k < 2; ++k) dst[m][k] = *(const LAS bf16x8*)(lds + PG8_SA(b, h) + aoff + m * 2048 + k * 1024); } while (0)
#define PG8_LDB(dst, b, h) do { _Pragma("unroll") for (int n = 0; n < 2; ++n) _Pragma("unroll") for (int k = 0; k < 2; ++k) dst[n][k] = *(const LAS bf16x8*)(lds + PG8_SB(b, h) + boff + n * 2048 + k * 1024); } while (0)
#define PG8_MMA(ai, bj, At, Bt) do { __builtin_amdgcn_s_setprio(1); _Pragma("unroll") for (int m = 0; m < 4; ++m) _Pragma("unroll") for (int n = 0; n < 2; ++n) _Pragma("unroll") for (int k = 0; k < 2; ++k) \
        acc[ai][bj][m][n] = __builtin_amdgcn_mfma_f32_16x16x32_bf16(Bt[n][k], At[m][k], acc[ai][bj][m][n], 0, 0, 0); __builtin_amdgcn_s_setprio(0); } while (0)
#define PG8_WAIT_V(n) asm volatile("s_waitcnt vmcnt(" #n ")" ::: "memory")
#define PG8_WAIT_L(n) asm volatile("s_waitcnt lgkmcnt(" #n ")" ::: "memory")
#define PG8_BAR __builtin_amdgcn_s_barrier()
#define PG8_SCHED __builtin_amdgcn_sched_barrier(0)
    Unit cur, nxt; int ui = 0;
    if (!S.next(0, cur)) return;
    unsigned vAc[2][2], vAn[2][2];
    PG8_AOFF(vAc, cur);
    f32x4 acc[2][2][4][2];
#pragma unroll
    for (int a = 0; a < 2; ++a)
#pragma unroll
        for (int b = 0; b < 2; ++b)
#pragma unroll
            for (int m = 0; m < 4; ++m)
#pragma unroll
                for (int n = 0; n < 2; ++n) acc[a][b][m][n] = (f32x4){0.f, 0.f, 0.f, 0.f};
    bf16x8 At[4][2], B0[2][2], B1[2][2];
    const char* cA = cur.A; const char* cB = cur.B;
    PG8_STAGE(PG8_SB(0, 0), cB, voffB); PG8_STAGE(PG8_SB(0, 1), cB + hstep, voffB); PG8_STAGE(PG8_SA(0, 0), cA, vAc[0]); PG8_STAGE(PG8_SA(0, 1), cA, vAc[1]);
    if (wr == 1) PG8_BAR;
    PG8_WAIT_V(2); PG8_BAR;
    PG8_STAGE(PG8_SB(1, 0), cB + kstep, voffB); PG8_STAGE(PG8_SA(1, 0), cA + kstep, vAc[0]); PG8_STAGE(PG8_SB(1, 1), cB + hstep + kstep, voffB);
    PG8_WAIT_V(6); PG8_BAR;
    for (;;) {
        const bool has_next = S.next(ui + 1, nxt);
        if constexpr (Sched::EARLY_AOFF) {
            if (has_next) { PG8_AOFF(vAn, nxt); } else {
#pragma unroll
                for (int h = 0; h < 2; ++h)
#pragma unroll
                    for (int i = 0; i < 2; ++i) vAn[h][i] = vAc[h][i];
            }
        }
        const char* nA = has_next ? nxt.A : cA; const char* nB = has_next ? nxt.B : cB;
        for (int t = 0; t < nt; t += 2) {
            const bool last = (t == nt - 2);
            const char* a1 = cA + (size_t)(t + 1) * kstep;
            const char* a2 = last ? nA : cA + (size_t)(t + 2) * kstep; const char* b2 = last ? nB : cB + (size_t)(t + 2) * kstep;
            const char* a3 = a2 + kstep; const char* b3 = b2 + kstep;
            PG8_LDB(B0, 0, 0); PG8_LDB(B1, 0, 1); PG8_SCHED; PG8_LDA(At, 0, 0); PG8_STAGE(PG8_SA(1, 1), a1, vAc[1]);
            PG8_WAIT_V(8); PG8_WAIT_L(0); PG8_BAR; PG8_MMA(0, 0, At, B0); PG8_MMA(0, 1, At, B1); PG8_BAR; PG8_SCHED;
            if (last) {
                if constexpr (Sched::EARLY_AOFF) {
#pragma unroll
                    for (int h = 0; h < 2; ++h)
#pragma unroll
                        for (int i = 0; i < 2; ++i) vAc[h][i] = vAn[h][i];
                } else { if (has_next) PG8_AOFF(vAc, nxt); }
            }
            PG8_LDA(At, 0, 1); PG8_STAGE(PG8_SB(0, 0), b2, voffB); PG8_STAGE(PG8_SB(0, 1), b2 + hstep, voffB); PG8_STAGE(PG8_SA(0, 0), a2, vAc[0]);
            PG8_WAIT_V(8); PG8_WAIT_L(0); PG8_BAR; PG8_MMA(1, 0, At, B0); PG8_MMA(1, 1, At, B1); PG8_BAR; PG8_SCHED;
            PG8_LDB(B0, 1, 0); PG8_LDB(B1, 1, 1); PG8_SCHED; PG8_LDA(At, 1, 0); PG8_STAGE(PG8_SA(0, 1), a2, vAc[1]);
            PG8_WAIT_V(8); PG8_WAIT_L(0); PG8_BAR; PG8_MMA(0, 0, At, B0); PG8_MMA(0, 1, At, B1); PG8_BAR; PG8_SCHED;
            PG8_LDA(At, 1, 1); PG8_STAGE(PG8_SB(1, 0), b3, voffB); PG8_STAGE(PG8_SB(1, 1), b3 + hstep, voffB); PG8_STAGE(PG8_SA(1, 0), a3, vAc[0]);
            PG8_WAIT_V(8); PG8_WAIT_L(0); PG8_BAR; PG8_MMA(1, 0, At, B0); PG8_MMA(1, 1, At, B1); PG8_BAR; PG8_SCHED;
        }
        if constexpr (ALIGN_EPI) { if (wr == 0) PG8_BAR; }
        E(acc, cur, wr, wc, fr, fq);
        if (!has_next) break;
#pragma unroll
        for (int a = 0; a < 2; ++a)
#pragma unroll
            for (int b = 0; b < 2; ++b)
#pragma unroll
                for (int m = 0; m < 4; ++m)
#pragma unroll
                    for (int n = 0; n < 2; ++n) acc[a][b][m][n] = (f32x4){0.f, 0.f, 0.f, 0.f};
        cur = nxt; cA = nA; cB = nB; ++ui;
        if constexpr (ALIGN_EPI) { if (wr == 1) PG8_BAR; }
    }
    PG8_WAIT_V(0);
    if constexpr (!ALIGN_EPI) { if (wr == 0) PG8_BAR; }
    PG8_BAR;
#undef PG8_AOFF
#undef PG8_SA
#undef PG8_SB
#undef PG8_STAGE
#undef PG8_LDA
#undef PG8_LDB
#undef PG8_MMA
#undef PG8_WAIT_V
#undef PG8_WAIT_L
#undef PG8_BAR
#undef PG8_SCHED
}

struct StaticOrder {
    static constexpr bool EARLY_AOFF = true;
    const char* A; const char* Bt; int K, nM, nN, nwg, G, c;
    __device__ __forceinline__ void init(const void* A_, const void* Bt_, int Mr, int N, int K_, int G_, int c_) { A = (const char*)A_; Bt = (const char*)Bt_; K = K_; nM = Mr / BM; nN = N / BM; nwg = nM * nN; G = G_; c = c_; }
    __device__ __forceinline__ bool next(int i, Unit& u) const {
        const long L = (long)i * G + c; if (L >= nwg) return false;
        int wgid = (int)L; { const int q = nwg / NXCD, r = nwg % NXCD, xcd = wgid % NXCD, off = wgid / NXCD; wgid = (xcd < r ? xcd * (q + 1) : r * (q + 1) + (xcd - r) * q) + off; }
        const int nig = WGM * nN, gid = wgid / nig, fm = gid * WGM, gsz = (nM - fm) < WGM ? (nM - fm) : WGM;
        u.pm = fm + ((wgid % nig) % gsz); u.pn = (wgid % nig) / gsz; u.A = A; u.B = Bt + (size_t)u.pn * BM * K * 2; u.aux = 0; return true;
    }
    __device__ __forceinline__ unsigned a_off(const Unit& u, int r, int cc) const { return (unsigned)((u.pm * BM + r) * K + cc) * 2u; }
};
}

namespace attn {
constexpr int SLOT = 20480, NSLOT = 3, VOFF = 12288;
constexpr int LDS_WS = NSLOT * SLOT, LDS_OST = LDS_WS + 8 * 256, LDS_BYTES = LDS_OST + 8 * 4096;
struct Args { const bf16* Q; int qpitch, qhs; const bf16* K; const char* KA; int ka_rowb, ka_headb; const bf16* V; bf16* O; };
__device__ __forceinline__ int crow(int r, int hi) { return (r & 3) + 8 * (r >> 2) + 4 * hi; }
__device__ __forceinline__ void glds16(const void* gsrc, unsigned lds_dst) { unsigned keep;
    asm volatile("s_mov_b32 %0, m0\n\ts_mov_b32 m0, %2\n\ts_nop 0\n\tglobal_load_lds_dwordx4 %1, off\n\ts_mov_b32 m0, %0" : "=&s"(keep) : "v"(gsrc), "s"(lds_dst) : "memory"); }
typedef short v4i16_t __attribute__((ext_vector_type(4)));
__device__ __forceinline__ s16x4 vtr(const LAS char* p) { return __builtin_bit_cast(s16x4, __builtin_amdgcn_ds_read_tr16_b64_v4i16((LAS v4i16_t*)p)); }
#define ATT_WAIT_BAR(N) asm volatile("s_waitcnt vmcnt(" #N ") lgkmcnt(0)\n\ts_barrier" ::: "memory")

template <int MODE>
__device__ __forceinline__ void attn_unit(const int b, const int h, const int qb, const Args& T, LAS char* shm) {
    constexpr int NKS = (MODE == 0) ? 5 : 6, NCH = (MODE == 0) ? 9 : 12;
    const int tid = threadIdx.x, lane = tid & 63, r32 = lane & 31, hi = lane >> 5; const int wid = __builtin_amdgcn_readfirstlane(tid >> 6);
    const long rowbase = (long)b * SEQ; const int q0 = qb * 256;
    const int NT = 4 * qb + 4, myNT = 4 * qb + (wid >> 1) + 1;
    const unsigned lds0 = (unsigned)(uintptr_t)shm;
    LAS float* wsf = (LAS float*)(shm + LDS_WS) + wid * 64;
    bf16x8 qr[NKS];
    { const bf16* Qw = T.Q + (rowbase + q0 + wid * 32 + r32) * (long)T.qpitch + h * T.qhs;
#pragma unroll
      for (int d0 = 0; d0 < 4; ++d0) qr[d0] = *reinterpret_cast<const bf16x8*>(Qw + d0 * 16 + hi * 8);
      if constexpr (MODE == 0) { const short one = (short)0x3F80; qr[4] = hi == 0 ? (bf16x8){one, one, one, 0, 0, 0, 0, 0} : (bf16x8){0, 0, 0, 0, 0, 0, 0, 0}; }
      else {
#pragma unroll
        for (int d0 = 4; d0 < 6; ++d0) qr[d0] = *reinterpret_cast<const bf16x8*>(Qw + d0 * 16 + hi * 8); } }
    const char* src[3]; unsigned dsto[3]; unsigned stepb[3];
#pragma unroll
    for (int j = 0; j < 3; ++j) { const int p = wid + 8 * j;
        if (p < 8) { src[j] = (const char*)(T.K + (rowbase + lane) * 1024 + h * 64 + p * 8); stepb[j] = 64u * 2048u; dsto[j] = (unsigned)p * 1024u; }
        else if (p < NCH) { src[j] = T.KA + (rowbase + lane) * (long)T.ka_rowb + h * T.ka_headb + (p - 8) * 16; stepb[j] = 64u * (unsigned)T.ka_rowb; dsto[j] = (unsigned)p * 1024u; }
        else { const int v = (p - NCH) & 7; src[j] = (const char*)(T.V + (rowbase + 16 * (v & 3) + (lane >> 2)) * 1024 + h * 64 + (v >> 2) * 32 + (lane & 3) * 8); stepb[j] = 64u * 2048u; dsto[j] = (unsigned)(VOFF + v * 1024); } }
#define ATT_DMA(t, slotoff) do { _Pragma("unroll") for (int _j = 0; _j < 3; ++_j) \
        glds16(src[_j] + (size_t)(t) * stepb[_j], (unsigned)__builtin_amdgcn_readfirstlane(lds0 + (unsigned)(slotoff) + dsto[_j])); } while (0)
    ATT_DMA(0, 0); ATT_DMA(1, SLOT);
    float mrun = -INFINITY, lrun = 0.f; f32x16 o[2]; o[0] = f32x16{}; o[1] = f32x16{};
    int sl_cur = 0, sl_n2 = 2 * SLOT;
    const int qloc = 32 * (wid & 1) + r32;
    for (int t = 0; t < NT; ++t) {
        if (t + 1 < NT) { ATT_WAIT_BAR(3); } else { ATT_WAIT_BAR(0); }
        if (t + 2 < NT) ATT_DMA(t + 2, sl_n2);
        if (t < myNT) {
            const LAS char* sb = shm + sl_cur;
            f32x16 p0 = f32x16{}, p1 = f32x16{};
#pragma unroll
            for (int d0 = 0; d0 < NKS; ++d0) {
                const int c_off = (MODE == 0 && d0 == 4) ? 8 * 1024 : (2 * d0) * 1024 + hi * 1024;
                const LAS char* ka = sb + c_off + r32 * 16;
                const bf16x8 k0 = *(const LAS bf16x8*)(ka), k1 = *(const LAS bf16x8*)(ka + 512);
                p0 = __builtin_amdgcn_mfma_f32_32x32x16_bf16(k0, qr[d0], p0, 0, 0, 0);
                p1 = __builtin_amdgcn_mfma_f32_32x32x16_bf16(k1, qr[d0], p1, 0, 0, 0);
            }
            if constexpr (MODE == 0) {
                if (t == myNT - 1) {
#pragma unroll
                    for (int r = 0; r < 16; ++r) { const int kv = crow(r, hi); if (kv > qloc) p0[r] = -INFINITY; if (kv + 32 > qloc) p1[r] = -INFINITY; }
                }
            }
            float mx = fmaxf(p0[0], p1[0]);
#pragma unroll
            for (int r = 1; r < 16; ++r) mx = fmaxf(mx, fmaxf(p0[r], p1[r]));
            mx = fmaxf(mx, __shfl_xor(mx, 32));
            const float mnew = fmaxf(mrun, mx);
            if (__any(mnew > mrun)) {
                const float f = __builtin_amdgcn_exp2f(mrun - mnew);
                lrun *= f; mrun = mnew;
                if (hi == 0) wsf[r32] = f;
#pragma unroll
                for (int j = 0; j < 4; ++j) { const f32x4 fv = *(const LAS f32x4*)(wsf + 8 * j + 4 * hi);
#pragma unroll
                    for (int i = 0; i < 4; ++i) { o[0][4 * j + i] *= fv[i]; o[1][4 * j + i] *= fv[i]; } }
            }
            float sacc = 0.f;
#pragma unroll
            for (int r = 0; r < 16; ++r) { p0[r] = __builtin_amdgcn_exp2f(p0[r] - mrun); p1[r] = __builtin_amdgcn_exp2f(p1[r] - mrun); sacc += p0[r] + p1[r]; }
            lrun += sacc;
            u32x4 pw[4];
#pragma unroll
            for (int i = 0; i < 4; ++i) { pw[0][i] = cvt_pk_bf16(p0[2 * i], p0[2 * i + 1]); pw[1][i] = cvt_pk_bf16(p0[8 + 2 * i], p0[9 + 2 * i]);
                                          pw[2][i] = cvt_pk_bf16(p1[2 * i], p1[2 * i + 1]); pw[3][i] = cvt_pk_bf16(p1[8 + 2 * i], p1[9 + 2 * i]); }
            const LAS char* vp = sb + VOFF + ((lane >> 4) & 1) * 32 + (lane & 3) * 8 + (4 * hi + ((lane & 15) >> 2)) * 64;
#pragma unroll
            for (int d0 = 0; d0 < 2; ++d0)
#pragma unroll
                for (int ks = 0; ks < 4; ++ks) {
                    const s16x4 lo = vtr(vp + d0 * 4096 + ks * 1024), hh = vtr(vp + d0 * 4096 + ks * 1024 + 512);
                    const bf16x8 vf = (bf16x8){lo[0], lo[1], lo[2], lo[3], hh[0], hh[1], hh[2], hh[3]};
                    o[d0] = __builtin_amdgcn_mfma_f32_32x32x16_bf16(__builtin_bit_cast(bf16x8, pw[ks]), vf, o[d0], 0, 0, 0);
                }
        }
        sl_cur = (sl_cur == 2 * SLOT) ? 0 : sl_cur + SLOT; sl_n2 = (sl_n2 == 2 * SLOT) ? 0 : sl_n2 + SLOT;
    }
    lrun += __shfl_xor(lrun, 32);
    if (hi == 0) wsf[r32] = 1.0f / lrun;
    float rli[16];
#pragma unroll
    for (int j = 0; j < 4; ++j) { const f32x4 fv = *(const LAS f32x4*)(wsf + 8 * j + 4 * hi); rli[4 * j] = fv[0]; rli[4 * j + 1] = fv[1]; rli[4 * j + 2] = fv[2]; rli[4 * j + 3] = fv[3]; }
    LAS bf16* stg = (LAS bf16*)(shm + LDS_OST) + wid * 2048;
#pragma unroll
    for (int r = 0; r < 16; ++r) { const int orow = crow(r, hi);
#pragma unroll
        for (int d0 = 0; d0 < 2; ++d0) stg[orow * 64 + d0 * 32 + r32] = (bf16)(cvt_pk_bf16(o[d0][r] * rli[r], 0.f) & 0xffffu); }
    bf16* Ow = T.O + (rowbase + q0 + wid * 32) * 1024 + h * 64;
#pragma unroll
    for (int i = 0; i < 4; ++i) { const int row = i * 8 + (lane >> 3), ch = lane & 7; const u32x4 v = *(const LAS u32x4*)(stg + row * 64 + ch * 8); *(u32x4*)(Ow + (long)row * 1024 + ch * 8) = v; }
    asm volatile("s_waitcnt lgkmcnt(0)\n\ts_barrier" ::: "memory");
#undef ATT_DMA
}
template <int MODE>
__device__ __forceinline__ void attn_phase(LAS char* lds, const Args& T, int vcu, int G) {
    for (int pu = vcu; pu < BATCH * NH * 4; pu += G) { const int bh = pu >> 2, s = pu & 3;
        attn_unit<MODE>(bh / NH, bh % NH, s, T, lds);
        attn_unit<MODE>(bh / NH, bh % NH, 7 - s, T, lds); }
}
#undef ATT_WAIT_BAR
}

constexpr size_t MiB = 1u << 20;
constexpr size_t WS_CTL = 0, CTL_ZERO_BYTES = 1 * MiB;
constexpr int CW_TMO = 0, CW_BAR = 4096, CW_CNT = 8192;
constexpr size_t WS_SSKV = 256 * 1024, WS_SSQ = 320 * 1024;
constexpr size_t WS_ROPE = 1 * MiB;
constexpr size_t WS_MODP = 3 * MiB;
constexpr size_t WS_MODF = 7 * MiB - 512 * 1024;
constexpr size_t WS_LF = 7 * MiB;
constexpr size_t WS_ROUTE = 8 * MiB;
constexpr size_t WS_LIST = 8 * MiB + 512 * 1024;
constexpr size_t WS_WLIST = 9 * MiB + 512 * 1024;
constexpr size_t WS_KB = 10 * MiB + 512 * 1024;
constexpr size_t WS_KR = 14 * MiB + 512 * 1024;
constexpr size_t WS_W = 16 * MiB;
constexpr size_t WS_WIN = WS_W, WS_WO0 = WS_WIN + 6 * MiB, WS_WDN = WS_WO0 + 2 * MiB, WS_WUP = WS_WDN + 512 * 1024, WS_WDQ = WS_WUP + 1 * MiB,
                 WS_WUQ = WS_WDQ + 1536 * 1024, WS_WO1 = WS_WUQ + 2304 * 1024;
static_assert(WS_WO1 + 2 * MiB <= 32 * MiB, "weights");
constexpr size_t WS_EW = 32 * MiB;
constexpr size_t EW_LAYER = 48 * MiB, EW_D = 32 * MiB;
constexpr size_t WS_XR = 128 * MiB;
constexpr size_t WS_T = 192 * MiB;
constexpr size_t WS_H = WS_T, WS_Q = WS_T + 32 * MiB, WS_K = WS_T + 64 * MiB, WS_V = WS_T + 96 * MiB;
constexpr size_t WS_ACT = WS_T + 32 * MiB, WS_Y = WS_T + 68 * MiB;
constexpr size_t WS_HKV = WS_T, WS_H1 = WS_T + 32 * MiB, WS_CKV = WS_T + 118 * MiB, WS_CQ = WS_T + 126 * MiB;
constexpr size_t WS_QCAT = WS_T, WS_KN = WS_T + 48 * MiB, WS_V2 = WS_T + 80 * MiB, WS_O2 = WS_T + 118 * MiB;
constexpr size_t WS_END = WS_T + 150 * MiB;
static_assert(WS_Y + (size_t)36864 * 1024 * 2 <= WS_END && WS_CQ + (size_t)M * QRANK * 2 <= WS_END && WS_V2 + 32 * MiB <= WS_CKV && WS_O2 + 32 * MiB <= WS_END, "ws map");
constexpr int MOE_ROWS = 36864;

constexpr int LDS_BYTES = 160 * 1024;
constexpr int LDS_MISC = LDS_BYTES - 1024;
static_assert(pg8::STAGE_BYTES <= LDS_MISC && attn::LDS_BYTES <= LDS_MISC, "lds");

#define RLX_AGENT __ATOMIC_RELAXED, __HIP_MEMORY_SCOPE_AGENT

#define XB_TMO      128
#define XB_XCNT(j)  (256  + 64 * (j))
#define XB_XSUB(j)  (1280 + 64 * (j))
#define XB_XGEN(j)  (2304 + 64 * (j))
#define XB_TOP      3328
#define XB_TOPGEN   3392
#define XCD_BAR_WORDS 3456
#define XB_SPIN_CAP (1u << 18)

__device__ __forceinline__ unsigned xb_ld(unsigned* p)              { return __hip_atomic_load(p, __ATOMIC_RELAXED, __HIP_MEMORY_SCOPE_AGENT); }
__device__ __forceinline__ unsigned xb_add(unsigned* p, unsigned v) { return __hip_atomic_fetch_add(p, v, __ATOMIC_RELAXED, __HIP_MEMORY_SCOPE_AGENT); }
__device__ __forceinline__ unsigned xb_xcc_id() { return (unsigned)__builtin_amdgcn_s_getreg((3 << 11) | 20) & 0xFu; }
#define XB_SPIN(cond, bar) do { unsigned _sp = 0; while (cond) { __builtin_amdgcn_s_sleep(1); \
    if ((++_sp & 255u) == 0u) { if (xb_ld(&(bar)[XB_TMO])) break; if (_sp > XB_SPIN_CAP) { atomicAdd(&(bar)[XB_TMO], 1u); break; } } } } while (0)

struct XcdBarrier {
    unsigned* bar; unsigned x;
    volatile LAS unsigned* st;
};

__device__ __forceinline__ XcdBarrier xcd_barrier_post(unsigned* bar, volatile LAS unsigned* st) {
    XcdBarrier b; b.bar = bar; b.x = xb_xcc_id(); b.st = st;
    if (threadIdx.x == 0) (void)xb_add(&bar[XB_XCNT(b.x)], 1u);
    return b;
}
__device__ __forceinline__ void xcd_barrier_complete(unsigned* bar, unsigned x, unsigned& nloc, unsigned& nx) {
    const unsigned G = gridDim.x * gridDim.y * gridDim.z;
    unsigned sum, cnt, mine, sp = 0u;
    for (;;) {
        sum = 0u; cnt = 0u; mine = 0u;
#pragma unroll
        for (unsigned j = 0; j < 16; ++j) { const unsigned c = xb_ld(&bar[XB_XCNT(j)]); sum += c; cnt += (c > 0u) ? 1u : 0u; mine = (j == x) ? c : mine; }
        if (sum == G) break;
        __builtin_amdgcn_s_sleep(1);
        if ((++sp & 255u) == 0u) { if (xb_ld(&bar[XB_TMO])) break; if (sp > XB_SPIN_CAP) { atomicAdd(&bar[XB_TMO], 1u); break; } }
    }
    nloc = mine > 0u ? mine : 1u; nx = cnt > 0u ? cnt : 1u;
}

__device__ __forceinline__ void xcd_barrier(const XcdBarrier& b) {
    asm volatile("s_waitcnt vmcnt(0)" ::: "memory");
    __syncthreads();
    if (threadIdx.x == 0) {
        unsigned* bar = b.bar;
        __builtin_amdgcn_s_waitcnt(0);
        unsigned nloc = b.st[0], nx = b.st[1];
        if (nloc == 0u) { xcd_barrier_complete(bar, b.x, nloc, nx); b.st[0] = nloc; b.st[1] = nx; }
        const unsigned old = xb_add(&bar[XB_XSUB(b.x)], 1u);
        const unsigned gen = old / nloc;
        if (old + 1u == (gen + 1u) * nloc) {
            __builtin_amdgcn_fence(__ATOMIC_RELEASE, "agent");
            asm volatile("s_waitcnt vmcnt(0)" ::: "memory");
            const unsigned og = xb_add(&bar[XB_TOP], 1u);
            const unsigned tg = og / nx;
            if (og + 1u == (tg + 1u) * nx) xb_add(&bar[XB_TOPGEN], 1u);
            else XB_SPIN(xb_ld(&bar[XB_TOPGEN]) == tg, bar);
            __builtin_amdgcn_fence(__ATOMIC_ACQUIRE, "agent");
            xb_add(&bar[XB_XGEN(b.x)], 1u);
            asm volatile("s_waitcnt vmcnt(0)" ::: "memory");
        } else {
            XB_SPIN(xb_ld(&bar[XB_XGEN(b.x)]) == gen, bar);
            __builtin_amdgcn_fence(__ATOMIC_ACQUIRE, "agent");
            asm volatile("s_waitcnt vmcnt(0)" ::: "memory");
        }
    }
    __syncthreads();
}

struct Args { const void* in[27]; float* out; unsigned char* ws; int ph_lo, ph_hi; };
enum { I_X = 0, I_C, I_POS, I_A_NORM_G, I_A_W_IN, I_A_B_F, I_A_W_O, I_KV_NORM_G, I_KV_W_MOD, I_KV_B_MOD, I_KV_W_DOWN, I_KV_LATENT_G, I_KV_W_UP, I_B_NORM_G, I_B_W_DQ, I_B_Q_NORM_G,
       I_B_W_UQ, I_B_W_O, I_W_MOD, I_B_MOD, I_FFN_NORM_G, I_ROUTER_W, I_ROUTER_BIAS, I_EXP_W_GATE, I_EXP_W_UP, I_EXP_W_DOWN, I_FINAL_NORM_G };

__device__ __forceinline__ float wave_sum(float v) {
#pragma unroll
    for (int o = 1; o < 64; o <<= 1) v += __shfl_xor(v, o);
    return v;
}
__device__ __forceinline__ float mod_bias(const Args& a, int n) {
    return n < 12288 ? ((const float*)a.in[I_B_MOD])[n] : ((const float*)a.in[I_KV_B_MOD])[n - 12288];
}
__device__ __forceinline__ float mod_value(const Args& a, int b, int n) {
    const float* mp = (const float*)(a.ws + WS_MODP) + (size_t)b * MODN + n; float s = mod_bias(a, n);
#pragma unroll
    for (int kc = 0; kc < 8; ++kc) s += mp[(size_t)kc * 8 * MODN];
    return s;
}

template <class ColPtr>
__device__ __forceinline__ void transpose_item(const ColPtr& colptr, const int ld, const int K, bf16* WT, const float* kscale, LAS float* scr, const int kb, const int nb, const int lane) {
    const int k0 = 64 * kb, n0 = 32 * nb;
    const float* cp = colptr(n0 + (lane & 31)) + (size_t)(k0 + (lane >> 5)) * ld;
#pragma unroll 8
    for (int i = 0; i < 32; ++i) { const int kk = 2 * i + (lane >> 5); float v = cp[(size_t)(2 * i) * ld]; if (kscale) v *= kscale[k0 + kk]; scr[kk * 33 + (lane & 31)] = v; }
    asm volatile("s_waitcnt lgkmcnt(0)" ::: "memory");
    const int c = lane & 7;
#pragma unroll
    for (int j = 0; j < 4; ++j) { const int n = (lane >> 3) + 8 * j; const LAS float* s = scr + (8 * c) * 33 + n;
        u32x4 o; o.x = cvt_pk_bf16(s[0 * 33], s[1 * 33]); o.y = cvt_pk_bf16(s[2 * 33], s[3 * 33]); o.z = cvt_pk_bf16(s[4 * 33], s[5 * 33]); o.w = cvt_pk_bf16(s[6 * 33], s[7 * 33]);
        *(u32x4*)(WT + (size_t)(n0 + n) * K + k0 + 8 * c) = o; }
    asm volatile("s_waitcnt lgkmcnt(0)" ::: "memory");
}

__device__ __forceinline__ void p0_prologue(const Args& a, LAS unsigned char* lds, const int gw, const int NGW, const int wave, const int lane, const int tid) {
    unsigned char* ws = a.ws;
    LAS float* cT = (LAS float*)(lds + 69632);
    { const float* c = (const float*)a.in[I_C];
      for (int idx = tid; idx < 8 * 1024; idx += NTHR) { const int b = idx >> 10, k = idx & 1023; const float v = c[idx]; cT[k * 8 + b] = v / (1.f + __expf(-v)); } }
    __syncthreads();
    LAS float* scr = (LAS float*)(lds + wave * 8448);
    constexpr int I_MODT = 224 * 8;
    constexpr int I_WIN = 16 * 96, I_WO = 16 * 32, I_WDN = 16 * 8, I_WUP = 4 * 64, I_WDQ = 16 * 24, I_WUQ = 12 * 48, I_GU = 32 * 512, I_DN = 32 * 256;
    constexpr int NITEMS = I_MODT + I_WIN + I_WO + I_WDN + I_WUP + I_WDQ + I_WUQ + I_WO + I_GU + I_DN;
    for (int it = gw; it < NITEMS; it += NGW) {
        int r = it;
        if (r < I_MODT) {
            const int cg = r >> 3, kc = r & 7, k0 = kc * 128;
            const float* W; int ld, col0;
            if (cg < 96) { W = (const float*)a.in[I_W_MOD]; ld = 6144; col0 = cg * 64; }
            else if (cg < 192) { W = (const float*)a.in[I_W_MOD] + (size_t)1024 * 6144; ld = 6144; col0 = (cg - 96) * 64; }
            else { W = (const float*)a.in[I_KV_W_MOD]; ld = 2048; col0 = (cg - 192) * 64; }
            const float* wp = W + (size_t)k0 * ld + col0 + lane;
            float acc[8] = {0.f, 0.f, 0.f, 0.f, 0.f, 0.f, 0.f, 0.f};
#pragma unroll 8
            for (int kk = 0; kk < 128; ++kk) { const float w = wp[(size_t)kk * ld]; const f32x4 c0 = *(const LAS f32x4*)(cT + (k0 + kk) * 8), c1 = *(const LAS f32x4*)(cT + (k0 + kk) * 8 + 4);
                acc[0] += c0[0] * w; acc[1] += c0[1] * w; acc[2] += c0[2] * w; acc[3] += c0[3] * w; acc[4] += c1[0] * w; acc[5] += c1[1] * w; acc[6] += c1[2] * w; acc[7] += c1[3] * w; }
            float* mp = (float*)(ws + WS_MODP) + (size_t)kc * 8 * MODN + cg * 64 + lane;
#pragma unroll
            for (int b = 0; b < 8; ++b) mp[(size_t)b * MODN] = acc[b];
            continue;
        }
        r -= I_MODT;
        if (r < I_WIN) { const float* W = (const float*)a.in[I_A_W_IN]; transpose_item([=](int n) { return W + n; }, 3088, 1024, (bf16*)(ws + WS_WIN), nullptr, scr, r / 96, r % 96, lane); continue; } r -= I_WIN;
        if (r < I_WO) { const float* W = (const float*)a.in[I_A_W_O]; transpose_item([=](int n) { return W + n; }, 1024, 1024, (bf16*)(ws + WS_WO0), nullptr, scr, r / 32, r % 32, lane); continue; } r -= I_WO;
        if (r < I_WDN) { const float* W = (const float*)a.in[I_KV_W_DOWN]; transpose_item([=](int n) { return W + n; }, 288, 1024, (bf16*)(ws + WS_WDN), nullptr, scr, r / 8, r % 8, lane); continue; } r -= I_WDN;
        if (r < I_WUP) { const float* W = (const float*)a.in[I_KV_W_UP];
            transpose_item([=](int n) { const int nn = n & 1023, hh = nn >> 6, j = nn & 63; return W + hh * 128 + (n >> 10) * 64 + j; }, 2048, 256, (bf16*)(ws + WS_WUP), (const float*)a.in[I_KV_LATENT_G], scr, r / 64, r % 64, lane); continue; } r -= I_WUP;
        if (r < I_WDQ) { const float* W = (const float*)a.in[I_B_W_DQ]; transpose_item([=](int n) { return W + n; }, 768, 1024, (bf16*)(ws + WS_WDQ), nullptr, scr, r / 24, r % 24, lane); continue; } r -= I_WDQ;
        if (r < I_WUQ) { const float* W = (const float*)a.in[I_B_W_UQ];
            transpose_item([=](int n) { const int hh = n / 96, j = n - hh * 96; const int sc = j < 64 ? j : 64 + ((j - 64) & 1) * 16 + ((j - 64) >> 1); return W + hh * 96 + sc; }, 1536, 768, (bf16*)(ws + WS_WUQ), (const float*)a.in[I_B_Q_NORM_G], scr, r / 48, r % 48, lane); continue; } r -= I_WUQ;
        if (r < I_WO) { const float* W = (const float*)a.in[I_B_W_O]; transpose_item([=](int n) { return W + n; }, 1024, 1024, (bf16*)(ws + WS_WO1), nullptr, scr, r / 32, r % 32, lane); continue; } r -= I_WO;
        if (r < I_GU) { const int le = r >> 9, q = r & 511; const float* Wg = (const float*)a.in[I_EXP_W_GATE] + (size_t)le * 1024 * 512; const float* Wu = (const float*)a.in[I_EXP_W_UP] + (size_t)le * 1024 * 512;
            bf16* dst = (bf16*)(ws + WS_EW + (size_t)(le >> 4) * EW_LAYER) + (size_t)(le & 15) * 1024 * 1024;
            transpose_item([=](int n) { const int tt = n >> 8, u = (n >> 7) & 1, j = n & 127; return (u ? Wu : Wg) + tt * 128 + j; }, 512, 1024, dst, nullptr, scr, q / 32, q % 32, lane); continue; } r -= I_GU;
        { const int le = r >> 8, q = r & 255; const float* Wd = (const float*)a.in[I_EXP_W_DOWN] + (size_t)le * 512 * 1024;
            bf16* dst = (bf16*)(ws + WS_EW + (size_t)(le >> 4) * EW_LAYER + EW_D) + (size_t)(le & 15) * 1024 * 512;
            transpose_item([=](int n) { return Wd + n; }, 1024, 512, dst, nullptr, scr, q / 32, q % 32, lane); }
    }
    { const int* pos = (const int*)a.in[I_POS]; f32x2* tab = (f32x2*)(ws + WS_ROPE);
      for (int idx = gw * 64 + lane; idx < M * 16; idx += NGW * 64) { const int tok = idx >> 4, i = idx & 15;
          const float invf = exp2f(-(float)i * (13.287712379549449f / 16.0f)); const float ang = (float)pos[tok] * invf; tab[idx] = (f32x2){cosf(ang), sinf(ang)}; } }
}

template <int N> __device__ __forceinline__ float wave_reduce_multi(float (&v)[N], const int lane) {
    int n = N;
#pragma unroll
    for (int s = 32; n > 1; s >>= 1, n >>= 1) { const int half = n >> 1; const bool up = (lane & s) != 0;
#pragma unroll
        for (int i = 0; i < N / 2; ++i) if (i < half) { const float a = v[i], b = v[i + half]; const float send = up ? a : b, keep = up ? b : a; v[i] = keep + __shfl_xor(send, s); } }
    float r = v[0];
#pragma unroll
    for (int s = (64 / N) >> 1; s >= 1; s >>= 1) r += __shfl_xor(r, s);
    return r;
}

template <int MODE>
__device__ __forceinline__ void row_pass(const Args& a, LAS unsigned char* lds, const int vcu, const int G, const int wave, const int lane, const int tid) {
    constexpr int E = (MODE == 2) ? 32 : 16;
    constexpr bool COMBINE = (MODE == 2 || MODE == 4), PROJ = (MODE != 4), TWO = (MODE == 2);
    constexpr int LAYER = (MODE == 3 || MODE == 4) ? 1 : 0;
    unsigned char* ws = a.ws;
    LAS float* Wsm = (LAS float*)lds;
    LAS float* VA = (LAS float*)(lds + 131072);
    LAS float* VB = VA + 1024; LAS float* VA2 = VA + 2048; LAS float* VB2 = VA + 3072; LAS float* VG = VA + 4096;
    LAS float* RS = (LAS float*)(lds + 131072 + 20480);
    LAS int* LCNT = (LAS int*)(lds + 131072 + 20480 + 4096);
    LAS int* RREC = (LAS int*)(lds + 131072 + 20480 + 4096 + 256);
    LAS float* RW = (LAS float*)(lds + 131072 + 20480 + 4096 + 256 + 1024);
    if constexpr (PROJ) {
        const float* Wsrc; int ldw;
        if constexpr (MODE == 0) { Wsrc = (const float*)a.in[I_A_W_IN] + 3072; ldw = 3088; }
        else if constexpr (MODE == 2) { Wsrc = (const float*)a.in[I_KV_W_DOWN] + 256; ldw = 288; }
        else { Wsrc = (const float*)a.in[I_ROUTER_W]; ldw = 16; }
        for (int idx = tid; idx < 1024 * E; idx += NTHR) { const int k = idx / E, e = idx % E; const float v = Wsrc[(size_t)k * ldw + e];
            const int lk = (k >> 2) & 63, ridx = ((k >> 8) * 4 + (k & 3)) * 64 + lk; const int sw = (E == 16) ? ((lk >> 2) & 3) : ((lk >> 1) & 7);
            Wsm[ridx * E + (((e >> 2) ^ sw) << 2) + (e & 3)] = v; }
    }
    if constexpr (COMBINE) { if (tid == 0) { const int* cnt = (const int*)(ws + WS_CTL) + CW_CNT + LAYER * 16 * 64; int acc_ = 0;
            for (int e = 0; e < 16; ++e) { LCNT[e] = acc_; acc_ += (cnt[e * 64] + 255) >> 8; } } }
    for (int chunk = vcu; chunk < M / 64; chunk += G) {
        const int row0 = chunk * 64, b = row0 / SEQ;
        __syncthreads();
        for (int k = tid; k < 1024; k += NTHR) {
            if constexpr (MODE == 0) { VA[k] = ((const float*)a.in[I_A_NORM_G])[k] * (1.f + mod_value(a, b, 1024 + k)); VB[k] = mod_value(a, b, k); }
            if constexpr (MODE == 1 || MODE == 3) { VA[k] = ((const float*)a.in[I_FFN_NORM_G])[LAYER * 1024 + k] * (1.f + mod_value(a, b, LAYER * 6144 + 4096 + k)); VB[k] = mod_value(a, b, LAYER * 6144 + 3072 + k); }
            if constexpr (MODE == 2) { VA[k] = ((const float*)a.in[I_KV_NORM_G])[k] * (1.f + mod_value(a, b, 12288 + 1024 + k)); VB[k] = mod_value(a, b, 12288 + k);
                                       VA2[k] = ((const float*)a.in[I_B_NORM_G])[k] * (1.f + mod_value(a, b, 6144 + 1024 + k)); VB2[k] = mod_value(a, b, 6144 + k); }
            if constexpr (MODE == 4) { VA[k] = ((const float*)a.in[I_FINAL_NORM_G])[k]; }
            if constexpr (COMBINE) VG[k] = mod_value(a, b, LAYER * 6144 + 5120 + k);
        }
        if constexpr (MODE == 1 || MODE == 3) { if (tid < 32) LCNT[tid] = 0; }
        __syncthreads();
#pragma unroll 1
        for (int rr = 0; rr < 8; rr += 1) {
            float hx[1][16]; float pacc[1][E];
#pragma unroll
            for (int q = 0; q < 1; ++q) {
                const int lr = wave * 8 + rr + q, row = row0 + lr;
                f32x4 x[4];
                if constexpr (MODE == 0) { const f32x4* xr = (const f32x4*)((const float*)a.in[I_X] + (size_t)row * D) + lane;
#pragma unroll
                    for (int j = 0; j < 4; ++j) x[j] = xr[64 * j]; }
                else { const f32x4* xr = (const f32x4*)((const float*)(ws + WS_XR) + (size_t)row * D) + lane;
#pragma unroll
                    for (int j = 0; j < 4; ++j) x[j] = xr[64 * j]; }
                if constexpr (COMBINE) {
                    const int4 rt = ((const int4*)(ws + WS_ROUTE))[row];
                    const int base0 = LCNT[rt.x], base1 = LCNT[rt.z];
                    const u32x2* y0 = (const u32x2*)((const bf16*)(ws + WS_Y) + (size_t)(base0 * 256 + rt.y) * D) + lane;
                    const u32x2* y1 = (const u32x2*)((const bf16*)(ws + WS_Y) + (size_t)(base1 * 256 + rt.w) * D) + lane;
#pragma unroll
                    for (int j = 0; j < 4; ++j) { const u32x2 p = y0[64 * j], r2 = y1[64 * j]; const f32x4 g = *(const LAS f32x4*)(VG + 256 * j + 4 * lane);
                        x[j][0] += g[0] * (bflo(p.x) + bflo(r2.x)); x[j][1] += g[1] * (bfhi(p.x) + bfhi(r2.x)); x[j][2] += g[2] * (bflo(p.y) + bflo(r2.y)); x[j][3] += g[3] * (bfhi(p.y) + bfhi(r2.y)); }
                    if constexpr (MODE == 2) { f32x4* xw = (f32x4*)((float*)(ws + WS_XR) + (size_t)row * D) + lane;
#pragma unroll
                        for (int j = 0; j < 4; ++j) xw[64 * j] = x[j]; }
                }
                float ss = 0.f;
#pragma unroll
                for (int j = 0; j < 4; ++j) ss += (x[j][0] * x[j][0] + x[j][1] * x[j][1]) + (x[j][2] * x[j][2] + x[j][3] * x[j][3]);
                const float rstd = rsqrtf(wave_sum(ss) * (1.f / D) + EPS);
                if constexpr (MODE == 4) {
                    f32x4* ow = (f32x4*)(a.out + (size_t)row * D) + lane;
#pragma unroll
                    for (int j = 0; j < 4; ++j) { const f32x4 g = *(const LAS f32x4*)(VA + 256 * j + 4 * lane); ow[64 * j] = x[j] * rstd * g; }
                } else {
                    bf16* Hout = (bf16*)(ws + WS_H);
                    u32x2* hw = (u32x2*)(Hout + (size_t)row * D) + lane;
#pragma unroll
                    for (int j = 0; j < 4; ++j) { const f32x4 A = *(const LAS f32x4*)(VA + 256 * j + 4 * lane), Bv = *(const LAS f32x4*)(VB + 256 * j + 4 * lane);
                        const f32x4 hv = x[j] * rstd * A + Bv; hx[q][4 * j] = hv[0]; hx[q][4 * j + 1] = hv[1]; hx[q][4 * j + 2] = hv[2]; hx[q][4 * j + 3] = hv[3];
                        u32x2 w; w.x = cvt_pk_bf16(hv[0], hv[1]); w.y = cvt_pk_bf16(hv[2], hv[3]); hw[64 * j] = w; }
                    if constexpr (TWO) { u32x2* hw2 = (u32x2*)((bf16*)(ws + WS_H1) + (size_t)row * D) + lane;
#pragma unroll
                        for (int j = 0; j < 4; ++j) { const f32x4 A = *(const LAS f32x4*)(VA2 + 256 * j + 4 * lane), Bv = *(const LAS f32x4*)(VB2 + 256 * j + 4 * lane);
                            const f32x4 hv = x[j] * rstd * A + Bv; u32x2 w; w.x = cvt_pk_bf16(hv[0], hv[1]); w.y = cvt_pk_bf16(hv[2], hv[3]); hw2[64 * j] = w; } }
                }
            }
            if constexpr (PROJ) {
#pragma unroll
                for (int q = 0; q < 1; ++q)
#pragma unroll
                    for (int e = 0; e < E; ++e) pacc[q][e] = 0.f;
                const int sw = (E == 16) ? ((lane >> 2) & 3) : ((lane >> 1) & 7);
#pragma unroll
                for (int ji = 0; ji < 16; ++ji) {
                    const LAS float* wrow = Wsm + (ji * 64 + lane) * E;
#pragma unroll
                    for (int c = 0; c < E / 4; ++c) { const f32x4 w4 = *(const LAS f32x4*)(wrow + ((c ^ sw) << 2));
#pragma unroll
                        for (int q = 0; q < 1; ++q) { const float hv = hx[q][ji]; pacc[q][4 * c] += hv * w4[0]; pacc[q][4 * c + 1] += hv * w4[1]; pacc[q][4 * c + 2] += hv * w4[2]; pacc[q][4 * c + 3] += hv * w4[3]; } }
                    asm volatile("" ::: "memory");
                }
#pragma unroll
                for (int q = 0; q < 1; ++q) {
                    const int lr = wave * 8 + rr + q, row = row0 + lr;
                    const float v = wave_reduce_multi<E>(pacc[q], lane);
                    if constexpr (MODE == 0) { const int e = (lane >> 2) & 15; const float z = v + ((const float*)a.in[I_A_B_F])[e];
                        const float lf = z < 0.f ? z - log1pf(__expf(z)) : -log1pf(__expf(-z));
                        if ((lane & 3) == 0) ((float*)(ws + WS_LF))[(size_t)row * 16 + e] = lf; }
                    if constexpr (MODE == 1 || MODE == 3) { const int e = (lane >> 2) & 15; if ((lane & 3) == 0) RS[lr * 16 + e] = v; }
                    if constexpr (MODE == 2) { const int e = (lane >> 1) & 31, i = e & 15; const float partner = __shfl_xor(v, 32);
                        const f32x2 cs = ((const f32x2*)(ws + WS_ROPE))[(size_t)row * 16 + i];
                        const float o = (e < 16) ? v * cs[0] - partner * cs[1] : v * cs[0] + partner * cs[1];
                        if ((lane & 1) == 0) ((bf16*)(ws + WS_KR))[(size_t)row * 32 + 2 * i + (e >> 4)] = (bf16)(cvt_pk_bf16(o, 0.f) & 0xffffu); }
                }
            }
        }
        if constexpr (MODE == 1 || MODE == 3) {
            asm volatile("s_waitcnt lgkmcnt(0)" ::: "memory");
            if (lane < 8) {
                const int lr = wave * 8 + lane; const float* rb = (const float*)a.in[I_ROUTER_BIAS];
                float sc[16], sel[16];
#pragma unroll
                for (int e = 0; e < 16; ++e) { const float z = RS[lr * 16 + e]; sc[e] = 1.f / (1.f + expf(-z)); sel[e] = sc[e] + rb[e]; }
                int gbest = 0; float gs_best = -INFINITY;
#pragma unroll
                for (int g = 0; g < 4; ++g) { float m1 = -INFINITY, m2 = -INFINITY;
#pragma unroll
                    for (int j = 0; j < 4; ++j) { const float s = sel[4 * g + j]; if (s > m1) { m2 = m1; m1 = s; } else if (s > m2) m2 = s; }
                    const float gsum = m1 + m2; if (gsum > gs_best) { gs_best = gsum; gbest = g; } }
                float s4[4], c4[4];
#pragma unroll
                for (int j = 0; j < 4; ++j) { float sv = 0.f, cv = 0.f;
#pragma unroll
                    for (int g = 0; g < 4; ++g) if (g == gbest) { sv = sel[4 * g + j]; cv = sc[4 * g + j]; }
                    s4[j] = sv; c4[j] = cv; }
                int i0 = 0;
#pragma unroll
                for (int j = 1; j < 4; ++j) if (s4[j] > s4[i0]) i0 = j;
                int i1 = (i0 == 0) ? 1 : 0;
#pragma unroll
                for (int j = 0; j < 4; ++j) if (j != i0 && j != i1 && s4[j] > s4[i1]) i1 = j;
                float w0 = 0.f, w1 = 0.f;
#pragma unroll
                for (int j = 0; j < 4; ++j) { if (j == i0) w0 = c4[j]; if (j == i1) w1 = c4[j]; }
                const float inv = 1.f / (w0 + w1);
                const int e0 = gbest * 4 + i0, e1 = gbest * 4 + i1;
                const int lp0 = __hip_atomic_fetch_add(LCNT + e0, 1, __ATOMIC_RELAXED, __HIP_MEMORY_SCOPE_WORKGROUP);
                const int lp1 = __hip_atomic_fetch_add(LCNT + e1, 1, __ATOMIC_RELAXED, __HIP_MEMORY_SCOPE_WORKGROUP);
                RREC[lr * 4 + 0] = e0; RREC[lr * 4 + 1] = lp0; RREC[lr * 4 + 2] = e1; RREC[lr * 4 + 3] = lp1; RW[lr * 2] = w0 * inv; RW[lr * 2 + 1] = w1 * inv;
            }
            __syncthreads();
            if (tid < 16) { int* cnt = (int*)(ws + WS_CTL) + CW_CNT + LAYER * 16 * 64; const int n = LCNT[tid];
                LCNT[16 + tid] = n ? __hip_atomic_fetch_add(cnt + tid * 64, n, RLX_AGENT) : 0; }
            __syncthreads();
            if (tid < 64) { const int row = row0 + tid; const int e0 = RREC[tid * 4], e1 = RREC[tid * 4 + 2]; const int p0 = LCNT[16 + e0] + RREC[tid * 4 + 1], p1 = LCNT[16 + e1] + RREC[tid * 4 + 3];
                int* list = (int*)(ws + WS_LIST); float* wl = (float*)(ws + WS_WLIST);
                list[(size_t)e0 * M + p0] = row; list[(size_t)e1 * M + p1] = row; wl[(size_t)e0 * M + p0] = RW[tid * 2]; wl[(size_t)e1 * M + p1] = RW[tid * 2 + 1];
                ((int4*)(ws + WS_ROUTE))[row] = make_int4(e0, p0, e1, p1); }
        }
    }
    __syncthreads();
}

namespace epi {
using pg8::Unit; using pg8::BM; using pg8::HALF;
__device__ __forceinline__ int opaque(int x) { asm volatile("" : "+v"(x)); return x; }
struct Bf16Split {
    static constexpr bool PERM = true;
    bf16* O; int ldc; int split_tiles; size_t split_stride; float scale0;
    __device__ __forceinline__ void operator()(const f32x4 (&acc)[2][2][4][2], const Unit& u, int wr, int wc, int fr, int fq) const {
        int pn = u.pn; bf16* base = O; float sc = 1.f;
        if (split_tiles) { const int t = pn / split_tiles; base += (size_t)t * split_stride; pn -= t * split_tiles; if (t == 0) sc = scale0; }
        const int row0 = u.pm * BM + opaque(wr * 64 + fr), col0 = pn * BM + wc * 32 + 8 * fq;
#pragma unroll
        for (int ai = 0; ai < 2; ++ai)
#pragma unroll
            for (int m = 0; m < 4; ++m) { bf16* rowp = base + (size_t)(row0 + ai * HALF + m * 16) * ldc + col0;
#pragma unroll
                for (int bj = 0; bj < 2; ++bj) { const f32x4 v0 = acc[ai][bj][m][0] * sc, v1 = acc[ai][bj][m][1] * sc;
                    u32x4 w; w.x = cvt_pk_bf16(v0[0], v0[1]); w.y = cvt_pk_bf16(v0[2], v0[3]); w.z = cvt_pk_bf16(v1[0], v1[1]); w.w = cvt_pk_bf16(v1[2], v1[3]);
                    *(u32x4*)(rowp + bj * HALF) = w; } }
    }
};
struct Resid {
    static constexpr bool PERM = false;
    const float* base; float* out; const float* gate;
    __device__ __forceinline__ void operator()(const f32x4 (&acc)[2][2][4][2], const Unit& u, int wr, int wc, int fr, int fq) const {
        const int b = (u.pm * BM) / SEQ; const int col0 = u.pn * BM + wc * 32 + 4 * fq; const int rb = opaque(wr * 64 + fr);
        f32x4 gv[2][2];
#pragma unroll
        for (int bj = 0; bj < 2; ++bj)
#pragma unroll
            for (int n = 0; n < 2; ++n) gv[bj][n] = *(const f32x4*)(gate + (size_t)b * MODN + col0 + bj * HALF + n * 16);
#pragma unroll
        for (int ai = 0; ai < 2; ++ai)
#pragma unroll
            for (int m = 0; m < 4; ++m) { const size_t off = (size_t)(u.pm * BM + ai * HALF + m * 16 + rb) * D + col0;
#pragma unroll
                for (int bj = 0; bj < 2; ++bj)
#pragma unroll
                    for (int n = 0; n < 2; ++n) { const f32x4 bs = *(const f32x4*)(base + off + bj * HALF + n * 16); *(f32x4*)(out + off + bj * HALF + n * 16) = bs + gv[bj][n] * acc[ai][bj][m][n]; } }
    }
};
struct GateUp {
    static constexpr bool PERM = true;
    bf16* act;
    __device__ __forceinline__ void operator()(const f32x4 (&acc)[2][2][4][2], const Unit& u, int wr, int wc, int fr, int fq) const {
        const int col0 = u.pn * 128 + wc * 32 + 8 * fq; const int rb = opaque(wr * 64 + fr);
#pragma unroll
        for (int ai = 0; ai < 2; ++ai)
#pragma unroll
            for (int m = 0; m < 4; ++m) { const size_t srow = (size_t)u.pm * BM + ai * HALF + m * 16 + rb; float r[8];
#pragma unroll
                for (int n = 0; n < 2; ++n)
#pragma unroll
                    for (int i = 0; i < 4; ++i) { const float g = acc[ai][0][m][n][i], up = acc[ai][1][m][n][i]; r[4 * n + i] = g * __builtin_amdgcn_rcpf(1.f + __builtin_amdgcn_exp2f(-g * LOG2E)) * up; }
                u32x4 w; w.x = cvt_pk_bf16(r[0], r[1]); w.y = cvt_pk_bf16(r[2], r[3]); w.z = cvt_pk_bf16(r[4], r[5]); w.w = cvt_pk_bf16(r[6], r[7]);
                *(u32x4*)(act + srow * DEXP + col0) = w; }
    }
};
struct Down {
    static constexpr bool PERM = true;
    bf16* Y; const float* wlist; const LAS int* tb; const LAS int* cn;
    __device__ __forceinline__ void operator()(const f32x4 (&acc)[2][2][4][2], const Unit& u, int wr, int wc, int fr, int fq) const {
        const int e = u.aux, mt = u.pm - tb[e], cnt = cn[e]; const int col0 = u.pn * BM + wc * 32 + 8 * fq; const int rb = opaque(wr * 64 + fr);
#pragma unroll
        for (int ai = 0; ai < 2; ++ai)
#pragma unroll
            for (int m = 0; m < 4; ++m) { const int lr = ai * HALF + m * 16 + rb, li = mt * BM + lr; const float w = li < cnt ? wlist[(size_t)e * M + li] : 0.f;
                bf16* rowp = Y + ((size_t)u.pm * BM + lr) * D + col0;
#pragma unroll
                for (int bj = 0; bj < 2; ++bj) { const f32x4 v0 = acc[ai][bj][m][0] * w, v1 = acc[ai][bj][m][1] * w;
                    u32x4 x; x.x = cvt_pk_bf16(v0[0], v0[1]); x.y = cvt_pk_bf16(v0[2], v0[3]); x.z = cvt_pk_bf16(v1[0], v1[1]); x.w = cvt_pk_bf16(v1[2], v1[3]);
                    *(u32x4*)(rowp + bj * HALF) = x; }
                asm volatile("" ::: "memory"); }
    }
};
struct LowRank {
    static constexpr bool PERM = true;
    bf16* O0; float* SS0; bf16* O1; float* SS1;
    __device__ __forceinline__ void operator()(const f32x4 (&acc)[2][2][4][2], const Unit& u, int wr, int wc, int fr, int fq) const {
        bf16* O = u.aux ? O1 : O0; float* SS = u.aux ? SS1 : SS0; const int ldc = u.aux ? QRANK : KVRANK;
        const int col0 = u.pn * BM + wc * 32 + 8 * fq; const int rb = opaque(wr * 64 + fr);
#pragma unroll
        for (int ai = 0; ai < 2; ++ai)
#pragma unroll
            for (int m = 0; m < 4; ++m) { const int row = u.pm * BM + ai * HALF + m * 16 + rb; float s = 0.f;
#pragma unroll
                for (int bj = 0; bj < 2; ++bj) { const f32x4 v0 = acc[ai][bj][m][0], v1 = acc[ai][bj][m][1];
                    s += (v0[0] * v0[0] + v0[1] * v0[1]) + (v0[2] * v0[2] + v0[3] * v0[3]) + (v1[0] * v1[0] + v1[1] * v1[1]) + (v1[2] * v1[2] + v1[3] * v1[3]);
                    u32x4 x; x.x = cvt_pk_bf16(v0[0], v0[1]); x.y = cvt_pk_bf16(v0[2], v0[3]); x.z = cvt_pk_bf16(v1[0], v1[1]); x.w = cvt_pk_bf16(v1[2], v1[3]);
                    *(u32x4*)(O + (size_t)row * ldc + col0 + bj * HALF) = x; }
                s += __shfl_xor(s, 16); s += __shfl_xor(s, 32);
                if (fq == 0) atomicAdd(SS + row, s);
                asm volatile("" ::: "memory"); }
    }
};
struct KvUp {
    static constexpr bool PERM = true;
    bf16* KN; bf16* V; const float* SS;
    __device__ __forceinline__ void operator()(const f32x4 (&acc)[2][2][4][2], const Unit& u, int wr, int wc, int fr, int fq) const {
        bf16* base = u.pn < 4 ? KN : V; const int col0 = (u.pn & 3) * BM + wc * 32 + 8 * fq; const int rb = opaque(wr * 64 + fr);
#pragma unroll
        for (int ai = 0; ai < 2; ++ai)
#pragma unroll
            for (int m = 0; m < 4; ++m) { const int row = u.pm * BM + ai * HALF + m * 16 + rb; const float rs = rsqrtf(SS[row] * (1.f / KVRANK) + EPS);
#pragma unroll
                for (int bj = 0; bj < 2; ++bj) { const f32x4 v0 = acc[ai][bj][m][0] * rs, v1 = acc[ai][bj][m][1] * rs;
                    u32x4 x; x.x = cvt_pk_bf16(v0[0], v0[1]); x.y = cvt_pk_bf16(v0[2], v0[3]); x.z = cvt_pk_bf16(v1[0], v1[1]); x.w = cvt_pk_bf16(v1[2], v1[3]);
                    *(u32x4*)(base + (size_t)row * D + col0 + bj * HALF) = x; }
                asm volatile("" ::: "memory"); }
    }
};
struct QUp {
    static constexpr bool PERM = true;
    bf16* Q; const float* SS; const f32x2* tab;
    __device__ __forceinline__ void operator()(const f32x4 (&acc)[2][2][4][2], const Unit& u, int wr, int wc, int fr, int fq) const {
        const int rb = opaque(wr * 64 + fr); const int cb = opaque(wc * 32 + 8 * fq);
#pragma unroll
        for (int ai = 0; ai < 2; ++ai)
#pragma unroll
            for (int m = 0; m < 4; ++m) { const int row = u.pm * BM + ai * HALF + m * 16 + rb; const float rs = rsqrtf(SS[row] * (1.f / QRANK) + EPS) * C2_MLA;
#pragma unroll
                for (int bj = 0; bj < 2; ++bj) { const int col0 = u.pn * BM + bj * HALF + cb; const int hq = col0 / 96, jj = col0 - hq * 96;
                    float v[8];
#pragma unroll
                    for (int n = 0; n < 2; ++n)
#pragma unroll
                        for (int i = 0; i < 4; ++i) v[4 * n + i] = acc[ai][bj][m][n][i] * rs;
                    if (jj >= 64) { const f32x4* tp = (const f32x4*)(tab + (size_t)row * 16 + ((jj - 64) >> 1)); const f32x4 t0 = tp[0], t1 = tp[1];
                        const float cs[4] = {t0[0], t0[2], t1[0], t1[2]}, sn[4] = {t0[1], t0[3], t1[1], t1[3]};
#pragma unroll
                        for (int p = 0; p < 4; ++p) { const float x1 = v[2 * p], x2 = v[2 * p + 1]; v[2 * p] = x1 * cs[p] - x2 * sn[p]; v[2 * p + 1] = x2 * cs[p] + x1 * sn[p]; } }
                    u32x4 x; x.x = cvt_pk_bf16(v[0], v[1]); x.y = cvt_pk_bf16(v[2], v[3]); x.z = cvt_pk_bf16(v[4], v[5]); x.w = cvt_pk_bf16(v[6], v[7]);
                    *(u32x4*)(Q + (size_t)row * QCAT + col0) = x; }
                asm volatile("" ::: "memory"); }
    }
};
}

template <bool GATHER> struct MoeOrder {
    static constexpr bool EARLY_AOFF = true;
    const LAS int* tb; const LAS int* cn; int G, c, nN; int K;
    const char* A; const char* Bt; size_t b_expert_bytes; const int* list;
    __device__ __forceinline__ bool next(int i, pg8::Unit& u) const {
        const long L = (long)i * G + c; const int total = tb[16] * nN; if (L >= total) return false;
        const int mg = (int)(L / nN), pn = (int)(L % nN); int e = 0;
#pragma unroll
        for (int x = 1; x < 16; ++x) if (mg >= tb[x]) e = x;
        u.pm = mg; u.pn = pn; u.aux = e; u.A = A; u.B = Bt + (size_t)e * b_expert_bytes + (size_t)pn * 256 * K * 2; return true;
    }
    __device__ __forceinline__ unsigned a_off(const pg8::Unit& u, int r, int cc) const {
        if constexpr (GATHER) { const int e = u.aux, li = (u.pm - tb[e]) * 256 + r; const int tok = li < cn[e] ? list[(size_t)e * M + li] : 0; return (unsigned)(tok * K + cc) * 2u; }
        return (unsigned)((u.pm * 256 + r) * K + cc) * 2u;
    }
};
struct LowRankOrder {
    static constexpr bool EARLY_AOFF = true;
    const char* A0; const char* B0; const char* A1; const char* B1; int G, c;
    __device__ __forceinline__ bool next(int i, pg8::Unit& u) const {
        const int L = i * G + c; if (L >= 256) return false;
        const int x = L & 7, j = L >> 3, sub = j & 3; u.pm = 8 * x + (j >> 2);
        if (sub == 0) { u.pn = 0; u.aux = 0; u.A = A0; u.B = B0; } else { u.pn = sub - 1; u.aux = 1; u.A = A1; u.B = B1 + (size_t)(sub - 1) * 256 * 1024 * 2; }
        return true;
    }
    __device__ __forceinline__ unsigned a_off(const pg8::Unit& u, int r, int cc) const { return (unsigned)((u.pm * 256 + r) * 1024 + cc) * 2u; }
};

constexpr int NPHASE = 17;
__global__ void __launch_bounds__(NTHR, 2) fwd_kernel(Args args) {
    extern __shared__ __attribute__((aligned(16))) unsigned char lds_raw[];
    LAS unsigned char* lds = (LAS unsigned char*)lds_raw;
    volatile LAS unsigned* MISC = (volatile LAS unsigned*)(lds + LDS_MISC);
#define PH_IDS int tid = threadIdx.x; asm volatile("" : "+v"(tid)); const int lane = tid & 63, wave = __builtin_amdgcn_readfirstlane(tid >> 6); const int gw = vcu * NWAVES + wave; (void)lane; (void)gw;
    const int G = gridDim.x; const int bx = blockIdx.x; const int vcu = (G % 8 == 0) ? (bx % 8) * (G / 8) + bx / 8 : bx;
    unsigned char* ws = args.ws;
    gu32* ctl = (gu32*)(ws + WS_CTL);
    for (int u = threadIdx.x; u < 256; u += NTHR) ((LAS unsigned*)(lds + LDS_MISC))[u] = 0u;
    __syncthreads();
    XcdBarrier bar = xcd_barrier_post((unsigned*)ctl + CW_BAR, MISC);
    const int lo = args.ph_lo, hi = args.ph_hi;
#ifndef PH_MASK
#define PH_MASK 0x1ffff
#endif
#define IN(k) (((PH_MASK >> (k)) & 1) && lo <= (k) && (k) < hi)
#define SEAM(k) do { if (IN(k) && IN((k) + 1)) xcd_barrier(bar); } while (0)
    const int NGW = G * NWAVES;
    const LAS int* TB = (const LAS int*)(lds + LDS_MISC + 64);
    const LAS int* CN = (const LAS int*)(lds + LDS_MISC + 192);
#define MOE_TABLES(L) do { __syncthreads(); if (threadIdx.x == 0) { const int* cnt = (const int*)(ws + WS_CTL) + CW_CNT + (L) * 16 * 64; int acc_ = 0; \
        LAS int* tbw = (LAS int*)(lds + LDS_MISC + 64); LAS int* cnw = (LAS int*)(lds + LDS_MISC + 192); \
        for (int e_ = 0; e_ < 16; ++e_) { const int c_ = cnt[e_ * 64]; tbw[e_] = acc_; cnw[e_] = c_; acc_ += (c_ + 255) >> 8; } tbw[16] = acc_; } __syncthreads(); } while (0)

    if (IN(0)) { PH_IDS p0_prologue(args, lds, gw, NGW, wave, lane, tid); }
    SEAM(0);
    if (IN(1)) { PH_IDS
        for (int idx = bx * NTHR + tid; idx < 8 * MODN; idx += G * NTHR) ((float*)(ws + WS_MODF))[idx] = mod_value(args, idx / MODN, idx % MODN);
        row_pass<0>(args, lds, vcu, G, wave, lane, tid);
    }
    SEAM(1);
    if (IN(2)) { PH_IDS
        for (int task = gw; task < BATCH * NH; task += NGW) { const int b = task / NH, h = task % NH;
            const float* lf = (const float*)(ws + WS_LF) + ((size_t)b * SEQ + 32 * lane) * 16 + h; float v[32]; float run = 0.f;
#pragma unroll
            for (int i = 0; i < 32; ++i) { run += lf[(size_t)i * 16]; v[i] = run; }
            float incl = run;
#pragma unroll
            for (int o = 1; o < 64; o <<= 1) { const float t = __shfl_up(incl, o); if (lane >= o) incl += t; }
            const float excl = incl - run;
            u32x4* kb = (u32x4*)(ws + WS_KB) + ((size_t)b * SEQ + 32 * lane) * 16 + h;
#pragma unroll
            for (int i = 0; i < 32; ++i) { const float bias = -(v[i] + excl) * LOG2E; const unsigned b1 = cvt_pk_bf16(bias, 0.f) & 0xffffu; const float r1 = bias - __uint_as_float(b1 << 16);
                const unsigned b2 = cvt_pk_bf16(r1, 0.f) & 0xffffu; const float r2 = r1 - __uint_as_float(b2 << 16); const unsigned b3 = cvt_pk_bf16(r2, 0.f) & 0xffffu;
                kb[(size_t)i * 16] = (u32x4){b1 | (b2 << 16), b3, 0u, 0u}; }
        }
        pg8::StaticOrder S; S.init(ws + WS_H, ws + WS_WIN, M, 3072, 1024, G, bx);
        epi::Bf16Split E{(bf16*)(ws + WS_Q), D, 4, (size_t)16 * MiB, C2_FOX};
        pg8::gemm_phase<epi::Bf16Split, pg8::StaticOrder, true>(lds, 1024, S, E);
    }
    SEAM(2);
    if (IN(3)) {
        const attn::Args T{(const bf16*)(ws + WS_Q), D, 64, (const bf16*)(ws + WS_K), (const char*)(ws + WS_KB), 256, 16, (const bf16*)(ws + WS_V), (bf16*)(ws + WS_Q)};
        attn::attn_phase<0>((LAS char*)lds, T, vcu, G);
    }
    SEAM(3);
    if (IN(4)) {
        pg8::StaticOrder S; S.init(ws + WS_Q, ws + WS_WO0, M, 1024, 1024, G, bx);
        epi::Resid E{(const float*)args.in[I_X], (float*)(ws + WS_XR), (const float*)(ws + WS_MODF) + 2048};
        pg8::gemm_phase<epi::Resid, pg8::StaticOrder, false>(lds, 1024, S, E);
    }
    SEAM(4);
    if (IN(5)) { PH_IDS row_pass<1>(args, lds, vcu, G, wave, lane, tid); }
    SEAM(5);
    if (IN(6)) {
        MOE_TABLES(0);
        MoeOrder<true> S{TB, CN, G, bx, 4, 1024, (const char*)(ws + WS_H), (const char*)(ws + WS_EW), (size_t)1024 * 1024 * 2, (const int*)(ws + WS_LIST)};
        epi::GateUp E{(bf16*)(ws + WS_ACT)};
        pg8::gemm_phase<epi::GateUp, MoeOrder<true>, true>(lds, 1024, S, E);
    }
    SEAM(6);
    if (IN(7)) {
        MOE_TABLES(0);
        MoeOrder<false> S{TB, CN, G, bx, 4, 512, (const char*)(ws + WS_ACT), (const char*)(ws + WS_EW + EW_D), (size_t)1024 * 512 * 2, nullptr};
        epi::Down E{(bf16*)(ws + WS_Y), (const float*)(ws + WS_WLIST), TB, CN};
        pg8::gemm_phase<epi::Down, MoeOrder<false>, true>(lds, 512, S, E);
    }
    SEAM(7);
    if (IN(8)) { PH_IDS row_pass<2>(args, lds, vcu, G, wave, lane, tid); }
    SEAM(8);
    if (IN(9)) {
        LowRankOrder S{(const char*)(ws + WS_HKV), (const char*)(ws + WS_WDN), (const char*)(ws + WS_H1), (const char*)(ws + WS_WDQ), G, bx};
        epi::LowRank E{(bf16*)(ws + WS_CKV), (float*)(ws + WS_SSKV), (bf16*)(ws + WS_CQ), (float*)(ws + WS_SSQ)};
        pg8::gemm_phase<epi::LowRank, LowRankOrder, false>(lds, 1024, S, E);
    }
    SEAM(9);
    if (IN(10)) {
        { pg8::StaticOrder S; S.init(ws + WS_CKV, ws + WS_WUP, M, 2048, 256, G, bx);
          epi::KvUp E{(bf16*)(ws + WS_KN), (bf16*)(ws + WS_V2), (const float*)(ws + WS_SSKV)};
          pg8::gemm_phase<epi::KvUp, pg8::StaticOrder, true>(lds, 256, S, E); }
        { pg8::StaticOrder S; S.init(ws + WS_CQ, ws + WS_WUQ, M, 1536, 768, G, bx);
          epi::QUp E{(bf16*)(ws + WS_QCAT), (const float*)(ws + WS_SSQ), (const f32x2*)(ws + WS_ROPE)};
          pg8::gemm_phase<epi::QUp, pg8::StaticOrder, true>(lds, 768, S, E); }
    }
    SEAM(10);
    if (IN(11)) {
        const attn::Args T{(const bf16*)(ws + WS_QCAT), QCAT, 96, (const bf16*)(ws + WS_KN), (const char*)(ws + WS_KR), 64, 0, (const bf16*)(ws + WS_V2), (bf16*)(ws + WS_O2)};
        attn::attn_phase<1>((LAS char*)lds, T, vcu, G);
    }
    SEAM(11);
    if (IN(12)) {
        pg8::StaticOrder S; S.init(ws + WS_O2, ws + WS_WO1, M, 1024, 1024, G, bx);
        epi::Resid E{(const float*)(ws + WS_XR), (float*)(ws + WS_XR), (const float*)(ws + WS_MODF) + 6144 + 2048};
        pg8::gemm_phase<epi::Resid, pg8::StaticOrder, false>(lds, 1024, S, E);
    }
    SEAM(12);
    if (IN(13)) { PH_IDS row_pass<3>(args, lds, vcu, G, wave, lane, tid); }
    SEAM(13);
    if (IN(14)) {
        MOE_TABLES(1);
        MoeOrder<true> S{TB, CN, G, bx, 4, 1024, (const char*)(ws + WS_H), (const char*)(ws + WS_EW + EW_LAYER), (size_t)1024 * 1024 * 2, (const int*)(ws + WS_LIST)};
        epi::GateUp E{(bf16*)(ws + WS_ACT)};
        pg8::gemm_phase<epi::GateUp, MoeOrder<true>, true>(lds, 1024, S, E);
    }
    SEAM(14);
    if (IN(15)) {
        MOE_TABLES(1);
        MoeOrder<false> S{TB, CN, G, bx, 4, 512, (const char*)(ws + WS_ACT), (const char*)(ws + WS_EW + EW_LAYER + EW_D), (size_t)1024 * 512 * 2, nullptr};
        epi::Down E{(bf16*)(ws + WS_Y), (const float*)(ws + WS_WLIST), TB, CN};
        pg8::gemm_phase<epi::Down, MoeOrder<false>, true>(lds, 512, S, E);
    }
    SEAM(15);
    if (IN(16)) { PH_IDS row_pass<4>(args, lds, vcu, G, wave, lane, tid); }
#undef IN
#undef PH_IDS
#undef SEAM
#undef MOE_TABLES
}

#ifndef MK_CUTS
#define MK_CUTS 0
#endif
extern "C" void kernel_launch(void* const* d_in, const int* in_sizes, int n_in, void* d_out, int out_size, void* d_ws, size_t ws_size, hipStream_t stream) {
    static int grid = 0;
    if (grid == 0) {
        if (n_in != 27 || in_sizes[0] != M * D || out_size != M * D || ws_size < WS_END) { fprintf(stderr, "kernel_launch: unexpected shapes (n_in %d, in0 %d, out %d, ws %zu need %zu); nothing launched\n", n_in, n_in > 0 ? in_sizes[0] : -1, out_size, ws_size, (size_t)WS_END); grid = -1; return; }
        int dev = 0, cus = 0, per_cu = 0;
        if (hipGetDevice(&dev) != hipSuccess || hipDeviceGetAttribute(&cus, hipDeviceAttributeMultiprocessorCount, dev) != hipSuccess) { grid = -1; return; }
        if (hipFuncSetAttribute((const void*)fwd_kernel, hipFuncAttributeMaxDynamicSharedMemorySize, LDS_BYTES) != hipSuccess) { fprintf(stderr, "kernel_launch: hipFuncSetAttribute failed\n"); grid = -1; return; }
        if (hipOccupancyMaxActiveBlocksPerMultiprocessor(&per_cu, (const void*)fwd_kernel, NTHR, LDS_BYTES) != hipSuccess || per_cu < 1) { fprintf(stderr, "kernel_launch: occupancy query says %d\n", per_cu); }
        (void)hipGetLastError();
        grid = cus;
    }
    if (grid < 0) return;
    if (hipMemsetAsync((char*)d_ws + WS_CTL, 0, CTL_ZERO_BYTES, stream) != hipSuccess) return;
    Args a{};
    for (int i = 0; i < 27; ++i) a.in[i] = d_in[i];
    a.out = (float*)d_out; a.ws = (unsigned char*)d_ws;
#if MK_CUTS
    for (int p = 0; p < NPHASE; ++p) { a.ph_lo = p; a.ph_hi = p + 1; hipLaunchKernelGGL(fwd_kernel, dim3(grid), dim3(NTHR), LDS_BYTES, stream, a); }
#else
    a.ph_lo = 0; a.ph_hi = NPHASE; hipLaunchKernelGGL(fwd_kernel, dim3(grid), dim3(NTHR), LDS_BYTES, stream, a);
#endif
}
```

```cpp
#include <hip/hip_runtime.h>
#include <cstdio>
#include <cstdint>

#define LAS __attribute__((address_space(3)))
#define GAS __attribute__((address_space(1)))
typedef unsigned short bf16;
typedef short bf16x8 __attribute__((ext_vector_type(8)));
typedef short s16x4 __attribute__((ext_vector_type(4)));
typedef float f32x2 __attribute__((ext_vector_type(2)));
typedef float f32x4 __attribute__((ext_vector_type(4)));
typedef float f32x16 __attribute__((ext_vector_type(16)));
typedef unsigned u32x2 __attribute__((ext_vector_type(2)));
typedef unsigned u32x4 __attribute__((ext_vector_type(4)));
typedef GAS unsigned gu32;

constexpr int BATCH = 8, SEQ = 2048, D = 1024, M = BATCH * SEQ, NH = 16;
constexpr int NEXP = 16, DEXP = 512;
constexpr int QRANK = 768, KVRANK = 256, QCAT = NH * 96;
constexpr float EPS = 1e-6f;
constexpr float LOG2E = 1.4426950408889634f;
constexpr float C2_FOX = 0.125f * LOG2E;
constexpr float C2_MLA = 0.10206207261596575f * LOG2E;
constexpr int MODN = 14336;
constexpr int NWAVES = 8, NTHR = 512;

__device__ __forceinline__ unsigned cvt_pk_bf16(float lo, float hi) { unsigned r; asm volatile("v_cvt_pk_bf16_f32 %0, %1, %2" : "=v"(r) : "v"(lo), "v"(hi)); return r; }
__device__ __forceinline__ float bf16_to_f(unsigned short b) { return __uint_as_float(((unsigned)b) << 16); }
__device__ __forceinline__ float bflo(unsigned w) { return __uint_as_float(w << 16); }
__device__ __forceinline__ float bfhi(unsigned w) { return __uint_as_float(w & 0xffff0000u); }

namespace pg8 {
constexpr int BM = 256, BK = 64, HALF = 128, HTB = HALF * BK * 2, STAGE_BYTES = 8 * HTB, NXCD = 8, WGM = 8;
__host__ __device__ __forceinline__ int lds_byte(int r, int c) { const int st = (r >> 4) * 2 + (c >> 5), rr = r & 15, cc = c & 31, ob = rr * 64 + cc * 2; return st * 1024 + (ob ^ (((ob >> 9) & 1) << 5)); }
__host__ __device__ __forceinline__ void stage_rc(int b, int& R, int& C) { const int st = b / 1024, sb = b % 1024, swz = sb ^ (((sb >> 9) & 1) << 5); R = (st >> 1) * 16 + swz / 64; C = (st & 1) * 32 + (swz % 64) / 2; }
__host__ __device__ __forceinline__ int perm32(int rho) { const int n = rho >> 4, i = rho & 15; return 8 * (i >> 2) + 4 * n + (i & 3); }

struct Unit { int pm, pn; const char* A; const char* B; int aux; };

template <class Epi, class Sched, bool ALIGN_EPI>
__device__ __forceinline__ void gemm_phase(LAS unsigned char* lds, const int K, const Sched& S, const Epi& E) {
    int tid_ = threadIdx.x; asm volatile("" : "+v"(tid_));
    const int tid = tid_, wid = __builtin_amdgcn_readfirstlane(tid >> 6), lane = tid & 63, wr = wid >> 2, wc = wid & 3, fr = lane & 15, fq = lane >> 4;
    const int nt = K / BK;
    unsigned voffB[2];
#pragma unroll
    for (int i = 0; i < 2; ++i) { int R, C; stage_rc(tid * 16 + i * 8192, R, C); const int Rb = Epi::PERM ? ((R & ~31) + perm32(R & 31)) : R;
        voffB[i] = (unsigned)(Rb * K + C) * 2u; }
#define PG8_AOFF(dst, unit) do { int t_ = threadIdx.x; asm volatile("" : "+v"(t_)); _Pragma("unroll") for (int i_ = 0; i_ < 2; ++i_) { int R_, C_; stage_rc(t_ * 16 + i_ * 8192, R_, C_); \
        _Pragma("unroll") for (int h_ = 0; h_ < 2; ++h_) dst[h_][i_] = S.a_off(unit, h_ * HALF + R_, C_); } } while (0)
    const size_t kstep = (size_t)(BK * 2);
    const size_t hstep = (size_t)HALF * K * 2;
    const unsigned ldsw = (unsigned)wid * 1024u;
    const int aoff = lds_byte(wr * 64 + fr, fq * 8), boff = lds_byte(wc * 32 + fr, fq * 8);
#define PG8_SA(b, h) (((b) * 2 + (h)) * HTB)
#define PG8_SB(b, h) ((4 + (b) * 2 + (h)) * HTB)
#define PG8_STAGE(bufoff, gbase, voff) do { _Pragma("unroll") for (int _i = 0; _i < 2; ++_i) { unsigned _vo = (voff)[_i]; asm volatile("" : "+v"(_vo));   \
        __builtin_amdgcn_global_load_lds((const unsigned*)((const char*)(gbase) + _vo), (LAS unsigned*)(lds + (bufoff) + ldsw + _i * 8192), 16, 0, 0); } } while (0)
#define PG8_LDA(dst, b, h) do { _Pragma("unroll") for (int m = 0; m < 4; ++m) _Pragma("unroll") for (int k = 0; k < 2; ++k) dst[m][k] = *(const LAS bf16x8*)(lds + PG8_SA(b, h) + aoff + m * 2048 + k * 1024); } while (0)
#define PG8_LDB(dst, b, h) do { _Pragma("unroll") for (int n = 0; n < 2; ++n) _Pragma("unroll") for (int k = 0; k < 2; ++k) dst[n][k] = *(const LAS bf16x8*)(lds + PG8_SB(b, h) + boff + n * 2048 + k * 1024); } while (0)
#define PG8_MMA(ai, bj, At, Bt) do { __builtin_amdgcn_s_setprio(1); _Pragma("unroll") for (int m = 0; m < 4; ++m) _Pragma("unroll") for (int n = 0; n < 2; ++n) _Pragma("unroll") for (int k = 0; k < 2; ++k) \
        acc[ai][bj][m][n] = __builtin_amdgcn_mfma_f32_16x16x32_bf16(Bt[n][k], At[m][k], acc[ai][bj][m][n], 0, 0, 0); __builtin_amdgcn_s_setprio(0); } while (0)
#define PG8_WAIT_V(n) asm volatile("s_waitcnt vmcnt(" #n ")" ::: "memory")
#define PG8_WAIT_L(n) asm volatile("s_waitcnt lgkmcnt(" #n ")" ::: "memory")
#define PG8_BAR __builtin_amdgcn_s_barrier()
#define PG8_SCHED __builtin_amdgcn_sched_barrier(0)
    Unit cur, nxt; int ui = 0;
    if (!S.next(0, cur)) return;
    unsigned vAc[2][2], vAn[2][2];
    PG8_AOFF(vAc, cur);
    f32x4 acc[2][2][4][2];
#pragma unroll
    for (int a = 0; a < 2; ++a)
#pragma unroll
        for (int b = 0; b < 2; ++b)
#pragma unroll
            for (int m = 0; m < 4; ++m)
#pragma unroll
                for (int n = 0; n < 2; ++n) acc[a][b][m][n] = (f32x4){0.f, 0.f, 0.f, 0.f};
    bf16x8 At[4][2], B0[2][2], B1[2][2];
    const char* cA = cur.A; const char* cB = cur.B;
    PG8_STAGE(PG8_SB(0, 0), cB, voffB); PG8_STAGE(PG8_SB(0, 1), cB + hstep, voffB); PG8_STAGE(PG8_SA(0, 0), cA, vAc[0]); PG8_STAGE(PG8_SA(0, 1), cA, vAc[1]);
    if (wr == 1) PG8_BAR;
    PG8_WAIT_V(2); PG8_BAR;
    PG8_STAGE(PG8_SB(1, 0), cB + kstep, voffB); PG8_STAGE(PG8_SA(1, 0), cA + kstep, vAc[0]); PG8_STAGE(PG8_SB(1, 1), cB + hstep + kstep, voffB);
    PG8_WAIT_V(6); PG8_BAR;
    for (;;) {
        const bool has_next = S.next(ui + 1, nxt);
        if constexpr (Sched::EARLY_AOFF) {
            if (has_next) { PG8_AOFF(vAn, nxt); } else {
#pragma unroll
                for (int h = 0; h < 2; ++h)
#pragma unroll
                    for (int i = 0; i < 2; ++i) vAn[h][i] = vAc[h][i];
            }
        }
        const char* nA = has_next ? nxt.A : cA; const char* nB = has_next ? nxt.B : cB;
        for (int t = 0; t < nt; t += 2) {
            const bool last = (t == nt - 2);
            const char* a1 = cA + (size_t)(t + 1) * kstep;
            const char* a2 = last ? nA : cA + (size_t)(t + 2) * kstep; const char* b2 = last ? nB : cB + (size_t)(t + 2) * kstep;
            const char* a3 = a2 + kstep; const char* b3 = b2 + kstep;
            PG8_LDB(B0, 0, 0); PG8_LDB(B1, 0, 1); PG8_SCHED; PG8_LDA(At, 0, 0); PG8_STAGE(PG8_SA(1, 1), a1, vAc[1]);
            PG8_WAIT_V(8); PG8_WAIT_L(0); PG8_BAR; PG8_MMA(0, 0, At, B0); PG8_MMA(0, 1, At, B1); PG8_BAR; PG8_SCHED;
            if (last) {
                if constexpr (Sched::EARLY_AOFF) {
#pragma unroll
                    for (int h = 0; h < 2; ++h)
#pragma unroll
                        for (int i = 0; i < 2; ++i) vAc[h][i] = vAn[h][i];
                } else { if (has_next) PG8_AOFF(vAc, nxt); }
            }
            PG8_LDA(At, 0, 1); PG8_STAGE(PG8_SB(0, 0), b2, voffB); PG8_STAGE(PG8_SB(0, 1), b2 + hstep, voffB); PG8_STAGE(PG8_SA(0, 0), a2, vAc[0]);
            PG8_WAIT_V(8); PG8_WAIT_L(0); PG8_BAR; PG8_MMA(1, 0, At, B0); PG8_MMA(1, 1, At, B1); PG8_BAR; PG8_SCHED;
            PG8_LDB(B0, 1, 0); PG8_LDB(B1, 1, 1); PG8_SCHED; PG8_LDA(At, 1, 0); PG8_STAGE(PG8_SA(0, 1), a2, vAc[1]);
            PG8_WAIT_V(8); PG8_WAIT_L(0); PG8_BAR; PG8_MMA(0, 0, At, B0); PG8_MMA(0, 1, At, B1); PG8_BAR; PG8_SCHED;
            PG8_LDA(At, 1, 1); PG8_STAGE(PG8_SB(1, 0), b3, voffB); PG8_STAGE(PG8_SB(1, 1), b3 + hstep, voffB); PG8_STAGE(PG8_SA(1, 0), a3, vAc[0]);
            PG8_WAIT_V(8); PG8_WAIT_L(0); PG8_BAR; PG8_MMA(1, 0, At, B0); PG8_MMA(1, 1, At, B1); PG8_BAR; PG8_SCHED;
        }
        if constexpr (ALIGN_EPI) { if (wr == 0) PG8_BAR; }
        E(acc, cur, wr, wc, fr, fq);
        if (!has_next) break;
#pragma unroll
        for (int a = 0; a < 2; ++a)
#pragma unroll
            for (int b = 0; b < 2; ++b)
#pragma unroll
                for (int m = 0; m < 4; ++m)
#pragma unroll
                    for (int n = 0; n < 2; ++n) acc[a][b][m][n] = (f32x4){0.f, 0.f, 0.f, 0.f};
        cur = nxt; cA = nA; cB = nB; ++ui;
        if constexpr (ALIGN_EPI) { if (wr == 1) PG8_BAR; }
    }
    PG8_WAIT_V(0);
    if constexpr (!ALIGN_EPI) { if (wr == 0) PG8_BAR; }
    PG8_BAR;
#undef PG8_AOFF
#undef PG8_SA
#undef PG8_SB
#undef PG8_STAGE
#undef PG8_LDA
#undef PG8_LDB
#undef PG8_MMA
#undef PG8_WAIT_V
#undef PG8_WAIT_L
#undef PG8_BAR
#undef PG8_SCHED
}

struct StaticOrder {
    static constexpr bool EARLY_AOFF = true;
    const char* A; const char* Bt; int K, nM, nN, nwg, G, c;
    __device__ __forceinline__ void init(const void* A_, const void* Bt_, int Mr, int N, int K_, int G_, int c_) { A = (const char*)A_; Bt = (const char*)Bt_; K = K_; nM = Mr / BM; nN = N / BM; nwg = nM * nN; G = G_; c = c_; }
    __device__ __forceinline__ bool next(int i, Unit& u) const {
        const long L = (long)i * G + c; if (L >= nwg) return false;
        int wgid = (int)L; { const int q = nwg / NXCD, r = nwg % NXCD, xcd = wgid % NXCD, off = wgid / NXCD; wgid = (xcd < r ? xcd * (q + 1) : r * (q + 1) + (xcd - r) * q) + off; }
        const int nig = WGM * nN, gid = wgid / nig, fm = gid * WGM, gsz = (nM - fm) < WGM ? (nM - fm) : WGM;
        u.pm = fm + ((wgid % nig) % gsz); u.pn = (wgid % nig) / gsz; u.A = A; u.B = Bt + (size_t)u.pn * BM * K * 2; u.aux = 0; return true;
    }
    __device__ __forceinline__ unsigned a_off(const Unit& u, int r, int cc) const { return (unsigned)((u.pm * BM + r) * K + cc) * 2u; }
};
}

namespace attn {
constexpr int SLOT = 20480, NSLOT = 5, VOFF = 12288;
constexpr int LDS_WS = NSLOT * SLOT, LDS_OST = LDS_WS + 8 * 256, LDS_BYTES = LDS_OST + 8 * 4096;
struct Args { const bf16* Q; int qpitch, qhs; const bf16* K; const char* KA; int ka_rowb, ka_headb; const bf16* V; bf16* O; };
__device__ __forceinline__ int crow(int r, int hi) { return (r & 3) + 8 * (r >> 2) + 4 * hi; }
__device__ __forceinline__ void glds16(const void* gsrc, unsigned lds_dst) { unsigned keep;
    asm volatile("s_mov_b32 %0, m0\n\ts_mov_b32 m0, %2\n\ts_nop 0\n\tglobal_load_lds_dwordx4 %1, off\n\ts_mov_b32 m0, %0" : "=&s"(keep) : "v"(gsrc), "s"(lds_dst) : "memory"); }
__device__ __forceinline__ void glds16s(const void* sbase, unsigned voff, unsigned lds_dst) { unsigned keep;
    asm volatile("s_mov_b32 %0, m0\n\ts_mov_b32 m0, %3\n\ts_nop 0\n\tglobal_load_lds_dwordx4 %1, %2\n\ts_mov_b32 m0, %0" : "=&s"(keep) : "v"(voff), "s"(sbase), "s"(lds_dst) : "memory"); }
typedef short v4i16_t __attribute__((ext_vector_type(4)));
__device__ __forceinline__ s16x4 vtr(const LAS char* p) { return __builtin_bit_cast(s16x4, __builtin_amdgcn_ds_read_tr16_b64_v4i16((LAS v4i16_t*)p)); }
#define ATT_WAIT_BAR(N) asm volatile("s_waitcnt vmcnt(" #N ") lgkmcnt(0)\n\ts_barrier" ::: "memory")
#define ATT_MX3(a, b, c) __builtin_fmaxf(__builtin_fmaxf((a), (b)), (c))
typedef __bf16 bf16x2_t __attribute__((ext_vector_type(2)));
__device__ __forceinline__ unsigned cvtpk_s(float lo, float hi) { f32x2 v = {lo, hi}; bf16x2_t b = __builtin_convertvector(v, bf16x2_t); return __builtin_bit_cast(unsigned, b); }
#define ATT_SGB(mask, n) __builtin_amdgcn_sched_group_barrier(mask, n, 0)

template <int MODE>
__device__ __forceinline__ void attn_unit(const int b, const int h, const int qb, const Args& T, LAS char* shm) {
    constexpr int NKS = (MODE == 0) ? 5 : 6, NCH = (MODE == 0) ? 9 : 12;
    constexpr float THR = (MODE == 0) ? 48.f : 8.f;
    const int tid = threadIdx.x, lane = tid & 63, r32 = lane & 31, hi = lane >> 5; const int wid = __builtin_amdgcn_readfirstlane(tid >> 6);
    const long rowbase = (long)b * SEQ; const int q0 = qb * 256;
    const int NT = 4 * qb + 4;
    const unsigned lds0 = (unsigned)(uintptr_t)shm;
    LAS float* wsf = (LAS float*)(shm + LDS_WS) + wid * 64;
    bf16x8 qr[NKS];
    { const bf16* Qw = T.Q + (rowbase + q0 + wid * 32 + r32) * (long)T.qpitch + h * T.qhs;
#pragma unroll
      for (int d0 = 0; d0 < 4; ++d0) qr[d0] = *reinterpret_cast<const bf16x8*>(Qw + d0 * 16 + hi * 8);
      if constexpr (MODE == 0) { const short one = (short)0x3F80; qr[4] = hi == 0 ? (bf16x8){one, one, one, 0, 0, 0, 0, 0} : (bf16x8){0, 0, 0, 0, 0, 0, 0, 0}; }
      else {
#pragma unroll
        for (int d0 = 4; d0 < 6; ++d0) qr[d0] = *reinterpret_cast<const bf16x8*>(Qw + d0 * 16 + hi * 8); } }
    const char* sbp[3]; int pkind[3]; unsigned dsto[3]; unsigned stepb[3];
#pragma unroll
    for (int j = 0; j < 3; ++j) { const int p = wid + 8 * j; const char* bp;
        if (p < 8) { bp = (const char*)(T.K + rowbase * 1024 + h * 64 + p * 8); pkind[j] = 0; stepb[j] = 64u * 2048u; dsto[j] = (unsigned)p * 1024u; }
        else if (p < NCH) { bp = T.KA + rowbase * (long)T.ka_rowb + h * T.ka_headb + (p - 8) * 16; pkind[j] = 1; stepb[j] = 64u * (unsigned)T.ka_rowb; dsto[j] = (unsigned)p * 1024u; }
        else { const int v = (p - NCH) & 7; bp = (const char*)(T.V + (rowbase + 16 * (v & 3)) * 1024 + h * 64 + (v >> 2) * 32); pkind[j] = 2; stepb[j] = 64u * 2048u; dsto[j] = (unsigned)(VOFF + v * 1024); }
        const unsigned long long bu = (unsigned long long)(uintptr_t)bp;
        sbp[j] = (const char*)(uintptr_t)(((unsigned long long)(unsigned)__builtin_amdgcn_readfirstlane((int)(bu >> 32)) << 32) | (unsigned)__builtin_amdgcn_readfirstlane((int)(unsigned)bu)); }
#define ATT_DMA(t, slotoff) do { int l_ = threadIdx.x & 63; asm volatile("" : "+v"(l_)); _Pragma("unroll") for (int _j = 0; _j < 3; ++_j) { \
        const unsigned vo_ = pkind[_j] == 0 ? (unsigned)l_ * 2048u : pkind[_j] == 1 ? (unsigned)l_ * (unsigned)T.ka_rowb : (unsigned)(l_ >> 2) * 2048u + (unsigned)(l_ & 3) * 16u; \
        glds16s(sbp[_j] + (size_t)(t) * stepb[_j], vo_, (unsigned)__builtin_amdgcn_readfirstlane(lds0 + (unsigned)(slotoff) + dsto[_j])); } } while (0)
    ATT_DMA(0, 0); ATT_DMA(1, SLOT); ATT_DMA(2, 2 * SLOT); ATT_DMA(3, 3 * SLOT);
    float mref = 0.f, lrun = 0.f; f32x16 o[2]; o[0] = f32x16{}; o[1] = f32x16{};
    f32x16 negm = f32x16{};
    const int qrel = wid * 32 + r32;
    bf16x8 kf[2 * NKS];
#define ATT_SBAR() __builtin_amdgcn_sched_barrier(0)
#define ATT_KRD(sb_, d0) do { const int c_off = (MODE == 0 && (d0) == 4) ? 8 * 1024 : (2 * (d0)) * 1024 + hi * 1024; \
            const LAS char* ka = (sb_) + c_off + r32 * 16; kf[2 * (d0)] = *(const LAS bf16x8*)(ka); kf[2 * (d0) + 1] = *(const LAS bf16x8*)(ka + 512); } while (0)
#define ATT_KPRE(slotoff) do { const LAS char* sbk_ = shm + (slotoff); ATT_KRD(sbk_, 0); ATT_SBAR(); } while (0)
    s16x4 vlo[8], vhh[8];
#define ATT_VRD(i, vp_) do { vlo[i] = vtr(vp_ + ((i) >> 2) * 4096 + ((i) & 3) * 1024); vhh[i] = vtr(vp_ + ((i) >> 2) * 4096 + ((i) & 3) * 1024 + 512); } while (0)
#define ATT_VP(sl_v) (shm + (sl_v) + VOFF + ((lane >> 4) & 1) * 32 + (lane & 3) * 8 + (4 * hi + ((lane & 15) >> 2)) * 64)
#define ATT_QKV(P0, P1, CINIT, sl_k, sl_v, WITHV) do { const LAS char* sbk_ = shm + (sl_k); const LAS char* vp_ = ATT_VP(sl_v); \
        _Pragma("unroll") for (int d0 = 0; d0 < NKS; ++d0) { \
            if (d0 == 0) { P0 = __builtin_amdgcn_mfma_f32_32x32x16_bf16(kf[0], qr[0], CINIT, 0, 0, 0); P1 = __builtin_amdgcn_mfma_f32_32x32x16_bf16(kf[1], qr[0], CINIT, 0, 0, 0); } \
            else { P0 = __builtin_amdgcn_mfma_f32_32x32x16_bf16(kf[2 * d0], qr[d0], P0, 0, 0, 0); P1 = __builtin_amdgcn_mfma_f32_32x32x16_bf16(kf[2 * d0 + 1], qr[d0], P1, 0, 0, 0); } \
            if (d0 == 0) ATT_KRD(sbk_, 1); if (d0 + 2 < NKS) ATT_KRD(sbk_, d0 + 2); \
            if (WITHV && d0 == NKS - 1) { ATT_VRD(0, vp_); ATT_VRD(4, vp_); } ATT_SBAR(); } } while (0)
#define ATT_MASK(P0, P1, tt) do { const int jb_ = (tt) - (NT - 4); \
        if constexpr (MODE == 0) { const int kl_ = qrel - 64 * jb_ - 4 * hi; _Pragma("unroll") for (int r = 0; r < 16; ++r) { const int kv = (r & 3) + 8 * (r >> 2); P0[r] = kv > kl_ ? -INFINITY : P0[r]; P1[r] = kv + 32 > kl_ ? -INFINITY : P1[r]; } } \
        else { const float pen_ = jb_ > (wid >> 1) ? -INFINITY : 0.f; _Pragma("unroll") for (int r = 0; r < 16; ++r) { P0[r] += pen_; P1[r] += pen_; } } } while (0)
#define ATT_ROWMAX(P0, P1, RM) do { float a_ = ATT_MX3(P0[0], P0[1], P1[0]), b_ = ATT_MX3(P0[2], P0[3], P1[1]); a_ = ATT_MX3(a_, P1[2], P1[3]); \
        _Pragma("unroll") for (int r = 4; r < 16; r += 4) { a_ = ATT_MX3(a_, P0[r], P0[r + 1]); b_ = ATT_MX3(b_, P0[r + 2], P0[r + 3]); a_ = ATT_MX3(a_, P1[r], P1[r + 1]); b_ = ATT_MX3(b_, P1[r + 2], P1[r + 3]); } \
        RM = __builtin_fmaxf(a_, b_); { auto rr_ = __builtin_amdgcn_permlane32_swap(__float_as_uint(RM), __float_as_uint(RM), false, false); RM = __builtin_fmaxf(__uint_as_float(rr_[0]), __uint_as_float(rr_[1])); } } while (0)
#define ATT_H1(PC0, PC1) do { float sacc_ = 0.f; \
        _Pragma("unroll") for (int r = 0; r < 16; ++r) { PC0[r] = __builtin_amdgcn_exp2f(PC0[r]); PC1[r] = __builtin_amdgcn_exp2f(PC1[r]); sacc_ += PC0[r] + PC1[r]; } \
        lrun += sacc_; \
        _Pragma("unroll") for (int i = 0; i < 4; ++i) { pw[0][i] = cvtpk_s(PC0[2 * i], PC0[2 * i + 1]); pw[1][i] = cvtpk_s(PC0[8 + 2 * i], PC0[9 + 2 * i]); \
                                                        pw[2][i] = cvtpk_s(PC1[2 * i], PC1[2 * i + 1]); pw[3][i] = cvtpk_s(PC1[8 + 2 * i], PC1[9 + 2 * i]); } } while (0)
#define ATT_VFR(i) (bf16x8){vlo[i][0], vlo[i][1], vlo[i][2], vlo[i][3], vhh[i][0], vhh[i][1], vhh[i][2], vhh[i][3]}
#define ATT_PVH(sl_v) do { const LAS char* vp_ = ATT_VP(sl_v); _Pragma("unroll") for (int ks = 0; ks < 4; ++ks) { \
            o[0] = __builtin_amdgcn_mfma_f32_32x32x16_bf16(__builtin_bit_cast(bf16x8, pw[ks]), ATT_VFR(ks), o[0], 0, 0, 0); \
            o[1] = __builtin_amdgcn_mfma_f32_32x32x16_bf16(__builtin_bit_cast(bf16x8, pw[ks]), ATT_VFR(4 + ks), o[1], 0, 0, 0); \
            if (ks == 0) { ATT_VRD(1, vp_); ATT_VRD(5, vp_); } if (ks + 2 < 4) { ATT_VRD(ks + 2, vp_); ATT_VRD(4 + ks + 2, vp_); } ATT_SBAR(); } } while (0)
#define ATT_VPRE(sl_v) do { const LAS char* vp_ = ATT_VP(sl_v); ATT_VRD(0, vp_); ATT_VRD(4, vp_); ATT_SBAR(); } while (0)
#define ATT_REF(PN0, PN1, tt, MASKED) do { if (MASKED) ATT_MASK(PN0, PN1, tt); float rm_; ATT_ROWMAX(PN0, PN1, rm_); \
        if (__builtin_expect(__any(rm_ > THR), 0)) { const float dl_ = __builtin_fmaxf(rm_, 0.f); mref += dl_; \
                _Pragma("unroll") for (int r = 0; r < 16; ++r) { PN0[r] -= dl_; PN1[r] -= dl_; } \
                _Pragma("unroll") for (int r = 0; r < 16; ++r) negm[r] = -mref; \
                const float f_ = __builtin_amdgcn_exp2f(-dl_); lrun *= f_; if (hi == 0) wsf[r32] = f_; \
                _Pragma("unroll") for (int j = 0; j < 4; ++j) { const f32x4 fv = *(const LAS f32x4*)(wsf + 8 * j + 4 * hi); \
                    _Pragma("unroll") for (int i = 0; i < 4; ++i) { o[0][4 * j + i] *= fv[i]; o[1][4 * j + i] *= fv[i]; } } } } while (0)
#define ATT_CLOSE(t, sl_dead) do { if ((t) + 3 < NT) { ATT_WAIT_BAR(3); } else { ATT_WAIT_BAR(0); } if ((t) + 4 < NT) ATT_DMA((t) + 4, sl_dead); } while (0)
    f32x16 pA0, pA1, pB0, pB1; u32x4 pw[4];
    ATT_WAIT_BAR(9);
    ATT_KPRE(0);
    { const f32x16 zero = f32x16{}; ATT_QKV(pA0, pA1, zero, 0, 0, false); }
    if (NT == 4) ATT_MASK(pA0, pA1, 0);
    { float rm; ATT_ROWMAX(pA0, pA1, rm); mref = rm;
#pragma unroll
      for (int r = 0; r < 16; ++r) { pA0[r] -= rm; pA1[r] -= rm; negm[r] = -rm; } }
    ATT_WAIT_BAR(6);
    int sm1 = 4 * SLOT, s0 = 0, s1 = SLOT;
#define ATT_ROT() do { sm1 = s0; s0 = s1; s1 = (s1 == 4 * SLOT) ? 0 : s1 + SLOT; } while (0)
    if (wid < 4) {
#define ATT_LEAD(PC0, PC1, PN0, PN1, t, MORE, MASKED) do { asm volatile("" : "+v"(PC0), "+v"(PC1)); \
            if (MORE) ATT_KPRE(s1); else ATT_VPRE(s0); ATT_H1(PC0, PC1); ATT_SBAR(); if (MORE) ATT_QKV(PN0, PN1, negm, s1, s0, true); ATT_PVH(s0); if (MORE) ATT_REF(PN0, PN1, (t) + 1, MASKED); ATT_CLOSE(t, sm1); ATT_ROT(); } while (0)
        int t = 0;
        for (; t + 6 < NT; t += 2) { ATT_LEAD(pA0, pA1, pB0, pB1, t, true, false); ATT_LEAD(pB0, pB1, pA0, pA1, t + 1, true, false); }
        for (; t + 2 < NT; t += 2) { ATT_LEAD(pA0, pA1, pB0, pB1, t, true, true); ATT_LEAD(pB0, pB1, pA0, pA1, t + 1, true, true); }
        ATT_LEAD(pA0, pA1, pB0, pB1, t, true, true);
        ATT_LEAD(pB0, pB1, pA0, pA1, t + 1, false, false);
#undef ATT_LEAD
    } else {
        ATT_KPRE(s1); ATT_H1(pA0, pA1); ATT_CLOSE(0, sm1); ATT_ROT();
#define ATT_TRAIL(t, MORE, MASKED) do { asm volatile("" : "+v"(pw[0]), "+v"(pw[1]), "+v"(pw[2]), "+v"(pw[3])); \
            ATT_QKV(pA0, pA1, negm, s0, sm1, true); ATT_PVH(sm1); ATT_REF(pA0, pA1, t, MASKED); if (MORE) ATT_KPRE(s1); ATT_H1(pA0, pA1); ATT_CLOSE(t, sm1); ATT_ROT(); } while (0)
        int t = 1;
        for (; t + 4 < NT; ++t) ATT_TRAIL(t, true, false);
        for (; t + 1 < NT; ++t) ATT_TRAIL(t, true, true);
        ATT_TRAIL(t, false, true);
        ATT_VPRE(sm1); ATT_PVH(sm1);
#undef ATT_TRAIL
    }
    lrun += __shfl_xor(lrun, 32);
    if (hi == 0) wsf[r32] = 1.0f / lrun;
    float rli[16];
#pragma unroll
    for (int j = 0; j < 4; ++j) { const f32x4 fv = *(const LAS f32x4*)(wsf + 8 * j + 4 * hi); rli[4 * j] = fv[0]; rli[4 * j + 1] = fv[1]; rli[4 * j + 2] = fv[2]; rli[4 * j + 3] = fv[3]; }
    LAS bf16* stg = (LAS bf16*)(shm + LDS_OST) + wid * 2048;
#pragma unroll
    for (int r = 0; r < 16; ++r) { const int orow = crow(r, hi);
#pragma unroll
        for (int d0 = 0; d0 < 2; ++d0) stg[orow * 64 + d0 * 32 + r32] = (bf16)(cvt_pk_bf16(o[d0][r] * rli[r], 0.f) & 0xffffu); }
    bf16* Ow = T.O + (rowbase + q0 + wid * 32) * 1024 + h * 64;
#pragma unroll
    for (int i = 0; i < 4; ++i) { const int row = i * 8 + (lane >> 3), ch = lane & 7; const u32x4 v = *(const LAS u32x4*)(stg + row * 64 + ch * 8); *(u32x4*)(Ow + (long)row * 1024 + ch * 8) = v; }
    asm volatile("s_waitcnt lgkmcnt(0)\n\ts_barrier" ::: "memory");
#undef ATT_DMA
#undef ATT_KRD
#undef ATT_KPRE
#undef ATT_QKV
#undef ATT_VRD
#undef ATT_VP
#undef ATT_VFR
#undef ATT_PVH
#undef ATT_VPRE
#undef ATT_SBAR
#undef ATT_MASK
#undef ATT_ROWMAX
#undef ATT_H1
#undef ATT_REF
#undef ATT_CLOSE
#undef ATT_ROT
}
template <int MODE>
__device__ __forceinline__ void attn_phase(LAS char* lds, const Args& T, int vcu, int G) {
    for (int pu2 = 2 * vcu; pu2 < BATCH * NH * 8; pu2 += ((pu2 & 1) ? 2 * G - 1 : 1)) { const int pu = pu2 >> 1, bh = pu >> 2, s = pu & 3;
        attn_unit<MODE>(bh / NH, bh % NH, (pu2 & 1) ? 7 - s : s, T, lds); }
}
#undef ATT_WAIT_BAR
#undef ATT_MX3
}

constexpr size_t MiB = 1u << 20;
constexpr size_t WS_CTL = 0, CTL_ZERO_BYTES = 1 * MiB;
constexpr int CW_TMO = 0, CW_BAR = 4096, CW_CNT = 8192;
constexpr size_t WS_SSKV = 256 * 1024, WS_SSQ = 320 * 1024;
constexpr size_t WS_ROPE = 1 * MiB;
constexpr size_t WS_MODP = 3 * MiB;
constexpr size_t WS_MODF = 7 * MiB - 512 * 1024;
constexpr size_t WS_LF = 7 * MiB;
constexpr size_t WS_ROUTE = 8 * MiB;
constexpr size_t WS_LIST = 8 * MiB + 512 * 1024;
constexpr size_t WS_WLIST = 9 * MiB + 512 * 1024;
constexpr size_t WS_KB = 10 * MiB + 512 * 1024;
constexpr size_t WS_KR = 14 * MiB + 512 * 1024;
constexpr size_t WS_W = 16 * MiB;
constexpr size_t WS_WIN = WS_W, WS_WO0 = WS_WIN + 6 * MiB, WS_WDN = WS_WO0 + 2 * MiB, WS_WUP = WS_WDN + 512 * 1024, WS_WDQ = WS_WUP + 1 * MiB,
                 WS_WUQ = WS_WDQ + 1536 * 1024, WS_WO1 = WS_WUQ + 2304 * 1024;
static_assert(WS_WO1 + 2 * MiB <= 32 * MiB, "weights");
constexpr size_t WS_EW = 32 * MiB;
constexpr size_t EW_LAYER = 48 * MiB, EW_D = 32 * MiB;
constexpr size_t WS_XR = 128 * MiB;
constexpr size_t WS_T = 192 * MiB;
constexpr size_t WS_H = WS_T, WS_Q = WS_T + 32 * MiB, WS_K = WS_T + 64 * MiB, WS_V = WS_T + 96 * MiB;
constexpr size_t WS_ACT = WS_T + 32 * MiB, WS_Y = WS_T + 68 * MiB;
constexpr size_t WS_HKV = WS_T, WS_H1 = WS_T + 32 * MiB, WS_CKV = WS_T + 118 * MiB, WS_CQ = WS_T + 126 * MiB;
constexpr size_t WS_QCAT = WS_T, WS_KN = WS_T + 48 * MiB, WS_V2 = WS_T + 80 * MiB, WS_O2 = WS_T + 118 * MiB;
constexpr size_t WS_END = WS_T + 150 * MiB;
static_assert(WS_Y + (size_t)36864 * 1024 * 2 <= WS_END && WS_CQ + (size_t)M * QRANK * 2 <= WS_END && WS_V2 + 32 * MiB <= WS_CKV && WS_O2 + 32 * MiB <= WS_END, "ws map");
constexpr int MOE_ROWS = 36864;

constexpr int LDS_BYTES = 160 * 1024;
constexpr int LDS_MISC = LDS_BYTES - 1024;
static_assert(pg8::STAGE_BYTES <= LDS_MISC && attn::LDS_BYTES <= LDS_MISC, "lds");

#define RLX_AGENT __ATOMIC_RELAXED, __HIP_MEMORY_SCOPE_AGENT

#define XB_TMO      128
#define XB_XCNT(j)  (256  + 64 * (j))
#define XB_XSUB(j)  (1280 + 64 * (j))
#define XB_XGEN(j)  (2304 + 64 * (j))
#define XB_TOP      3328
#define XB_TOPGEN   3392
#define XCD_BAR_WORDS 3456
#define XB_SPIN_CAP (1u << 18)

__device__ __forceinline__ unsigned xb_ld(unsigned* p)              { return __hip_atomic_load(p, __ATOMIC_RELAXED, __HIP_MEMORY_SCOPE_AGENT); }
__device__ __forceinline__ unsigned xb_add(unsigned* p, unsigned v) { return __hip_atomic_fetch_add(p, v, __ATOMIC_RELAXED, __HIP_MEMORY_SCOPE_AGENT); }
__device__ __forceinline__ unsigned xb_xcc_id() { return (unsigned)__builtin_amdgcn_s_getreg((3 << 11) | 20) & 0xFu; }
#define XB_SPIN(cond, bar) do { unsigned _sp = 0; while (cond) { __builtin_amdgcn_s_sleep(1); \
    if ((++_sp & 255u) == 0u) { if (xb_ld(&(bar)[XB_TMO])) break; if (_sp > XB_SPIN_CAP) { atomicAdd(&(bar)[XB_TMO], 1u); break; } } } } while (0)

struct XcdBarrier {
    unsigned* bar; unsigned x;
    volatile LAS unsigned* st;
};

__device__ __forceinline__ XcdBarrier xcd_barrier_post(unsigned* bar, volatile LAS unsigned* st) {
    XcdBarrier b; b.bar = bar; b.x = xb_xcc_id(); b.st = st;
    if (threadIdx.x == 0) (void)xb_add(&bar[XB_XCNT(b.x)], 1u);
    return b;
}
__device__ __forceinline__ void xcd_barrier_complete(unsigned* bar, unsigned x, unsigned& nloc, unsigned& nx) {
    const unsigned G = gridDim.x * gridDim.y * gridDim.z;
    unsigned sum, cnt, mine, sp = 0u;
    for (;;) {
        sum = 0u; cnt = 0u; mine = 0u;
#pragma unroll
        for (unsigned j = 0; j < 16; ++j) { const unsigned c = xb_ld(&bar[XB_XCNT(j)]); sum += c; cnt += (c > 0u) ? 1u : 0u; mine = (j == x) ? c : mine; }
        if (sum == G) break;
        __builtin_amdgcn_s_sleep(1);
        if ((++sp & 255u) == 0u) { if (xb_ld(&bar[XB_TMO])) break; if (sp > XB_SPIN_CAP) { atomicAdd(&bar[XB_TMO], 1u); break; } }
    }
    nloc = mine > 0u ? mine : 1u; nx = cnt > 0u ? cnt : 1u;
}

__device__ __forceinline__ void xcd_barrier(const XcdBarrier& b) {
    asm volatile("s_waitcnt vmcnt(0)" ::: "memory");
    __syncthreads();
    if (threadIdx.x == 0) {
        unsigned* bar = b.bar;
        __builtin_amdgcn_s_waitcnt(0);
        unsigned nloc = b.st[0], nx = b.st[1];
        if (nloc == 0u) { xcd_barrier_complete(bar, b.x, nloc, nx); b.st[0] = nloc; b.st[1] = nx; }
        const unsigned old = xb_add(&bar[XB_XSUB(b.x)], 1u);
        const unsigned gen = old / nloc;
        if (old + 1u == (gen + 1u) * nloc) {
            __builtin_amdgcn_fence(__ATOMIC_RELEASE, "agent");
            asm volatile("s_waitcnt vmcnt(0)" ::: "memory");
            const unsigned og = xb_add(&bar[XB_TOP], 1u);
            const unsigned tg = og / nx;
            if (og + 1u == (tg + 1u) * nx) xb_add(&bar[XB_TOPGEN], 1u);
            else XB_SPIN(xb_ld(&bar[XB_TOPGEN]) == tg, bar);
            __builtin_amdgcn_fence(__ATOMIC_ACQUIRE, "agent");
            xb_add(&bar[XB_XGEN(b.x)], 1u);
            asm volatile("s_waitcnt vmcnt(0)" ::: "memory");
        } else {
            XB_SPIN(xb_ld(&bar[XB_XGEN(b.x)]) == gen, bar);
            __builtin_amdgcn_fence(__ATOMIC_ACQUIRE, "agent");
            asm volatile("s_waitcnt vmcnt(0)" ::: "memory");
        }
    }
    __syncthreads();
}

struct Args { const void* in[27]; float* out; unsigned char* ws; int ph_lo, ph_hi; };
enum { I_X = 0, I_C, I_POS, I_A_NORM_G, I_A_W_IN, I_A_B_F, I_A_W_O, I_KV_NORM_G, I_KV_W_MOD, I_KV_B_MOD, I_KV_W_DOWN, I_KV_LATENT_G, I_KV_W_UP, I_B_NORM_G, I_B_W_DQ, I_B_Q_NORM_G,
       I_B_W_UQ, I_B_W_O, I_W_MOD, I_B_MOD, I_FFN_NORM_G, I_ROUTER_W, I_ROUTER_BIAS, I_EXP_W_GATE, I_EXP_W_UP, I_EXP_W_DOWN, I_FINAL_NORM_G };

__device__ __forceinline__ float wave_sum(float v) {
#pragma unroll
    for (int o = 1; o < 64; o <<= 1) v += __shfl_xor(v, o);
    return v;
}
__device__ __forceinline__ float mod_bias(const Args& a, int n) {
    return n < 12288 ? ((const float*)a.in[I_B_MOD])[n] : ((const float*)a.in[I_KV_B_MOD])[n - 12288];
}
__device__ __forceinline__ float mod_value(const Args& a, int b, int n) {
    const float* mp = (const float*)(a.ws + WS_MODP) + (size_t)b * MODN + n; float s = mod_bias(a, n);
#pragma unroll
    for (int kc = 0; kc < 8; ++kc) s += mp[(size_t)kc * 8 * MODN];
    return s;
}

template <class ColPtr>
__device__ __forceinline__ void transpose_item(const ColPtr& colptr, const int ld, const int K, bf16* WT, const float* kscale, LAS float* scr, const int kb, const int nb, const int lane) {
    const int k0 = 64 * kb, n0 = 32 * nb;
    const float* cp = colptr(n0 + (lane & 31)) + (size_t)(k0 + (lane >> 5)) * ld;
    float tv[32];
#pragma unroll
    for (int i = 0; i < 32; ++i) tv[i] = cp[(size_t)(2 * i) * ld];
#pragma unroll
    for (int i = 0; i < 32; ++i) { const int kk = 2 * i + (lane >> 5); float v = tv[i]; if (kscale) v *= kscale[k0 + kk]; scr[kk * 33 + (lane & 31)] = v; }
    asm volatile("s_waitcnt lgkmcnt(0)" ::: "memory");
    const int c = lane & 7;
#pragma unroll
    for (int j = 0; j < 4; ++j) { const int n = (lane >> 3) + 8 * j; const LAS float* s = scr + (8 * c) * 33 + n;
        u32x4 o; o.x = cvt_pk_bf16(s[0 * 33], s[1 * 33]); o.y = cvt_pk_bf16(s[2 * 33], s[3 * 33]); o.z = cvt_pk_bf16(s[4 * 33], s[5 * 33]); o.w = cvt_pk_bf16(s[6 * 33], s[7 * 33]);
        *(u32x4*)(WT + (size_t)(n0 + n) * K + k0 + 8 * c) = o; }
    asm volatile("s_waitcnt lgkmcnt(0)" ::: "memory");
}

__device__ __forceinline__ void p0_prologue(const Args& a, LAS unsigned char* lds, const int gw, const int NGW, const int wave, const int lane, const int tid) {
    unsigned char* ws = a.ws;
    LAS float* cT = (LAS float*)(lds + 69632);
    { const float* c = (const float*)a.in[I_C];
      for (int idx = tid; idx < 8 * 1024; idx += NTHR) { const int b = idx >> 10, k = idx & 1023; const float v = c[idx]; cT[k * 8 + b] = v / (1.f + __expf(-v)); } }
    __syncthreads();
    LAS float* scr = (LAS float*)(lds + wave * 8448);
    constexpr int I_MODT = 224 * 8;
    constexpr int I_WIN = 16 * 96, I_WO = 16 * 32, I_WDN = 16 * 8, I_WUP = 4 * 64, I_WDQ = 16 * 24, I_WUQ = 12 * 48, I_GU = 32 * 512, I_DN = 32 * 256;
    constexpr int NITEMS = I_MODT + I_WIN + I_WO + I_WDN + I_WUP + I_WDQ + I_WUQ + I_WO + I_GU + I_DN;
    for (int it = gw; it < NITEMS; it += NGW) {
        int r = it;
        if (r < I_MODT) {
            const int cg = r >> 3, kc = r & 7, k0 = kc * 128;
            const float* W; int ld, col0;
            if (cg < 96) { W = (const float*)a.in[I_W_MOD]; ld = 6144; col0 = cg * 64; }
            else if (cg < 192) { W = (const float*)a.in[I_W_MOD] + (size_t)1024 * 6144; ld = 6144; col0 = (cg - 96) * 64; }
            else { W = (const float*)a.in[I_KV_W_MOD]; ld = 2048; col0 = (cg - 192) * 64; }
            const float* wp = W + (size_t)k0 * ld + col0 + lane;
            float acc[8] = {0.f, 0.f, 0.f, 0.f, 0.f, 0.f, 0.f, 0.f};
#pragma unroll 8
            for (int kk = 0; kk < 128; ++kk) { const float w = wp[(size_t)kk * ld]; const f32x4 c0 = *(const LAS f32x4*)(cT + (k0 + kk) * 8), c1 = *(const LAS f32x4*)(cT + (k0 + kk) * 8 + 4);
                acc[0] += c0[0] * w; acc[1] += c0[1] * w; acc[2] += c0[2] * w; acc[3] += c0[3] * w; acc[4] += c1[0] * w; acc[5] += c1[1] * w; acc[6] += c1[2] * w; acc[7] += c1[3] * w; }
            float* mp = (float*)(ws + WS_MODP) + (size_t)kc * 8 * MODN + cg * 64 + lane;
#pragma unroll
            for (int b = 0; b < 8; ++b) mp[(size_t)b * MODN] = acc[b];
            continue;
        }
        r -= I_MODT;
        if (r < I_WIN) { const float* W = (const float*)a.in[I_A_W_IN]; transpose_item([=](int n) { return W + n; }, 3088, 1024, (bf16*)(ws + WS_WIN), nullptr, scr, r / 96, r % 96, lane); continue; } r -= I_WIN;
        if (r < I_WO) { const float* W = (const float*)a.in[I_A_W_O]; transpose_item([=](int n) { return W + n; }, 1024, 1024, (bf16*)(ws + WS_WO0), nullptr, scr, r / 32, r % 32, lane); continue; } r -= I_WO;
        if (r < I_WDN) { const float* W = (const float*)a.in[I_KV_W_DOWN]; transpose_item([=](int n) { return W + n; }, 288, 1024, (bf16*)(ws + WS_WDN), nullptr, scr, r / 8, r % 8, lane); continue; } r -= I_WDN;
        if (r < I_WUP) { const float* W = (const float*)a.in[I_KV_W_UP];
            transpose_item([=](int n) { const int nn = n & 1023, hh = nn >> 6, j = nn & 63; return W + hh * 128 + (n >> 10) * 64 + j; }, 2048, 256, (bf16*)(ws + WS_WUP), (const float*)a.in[I_KV_LATENT_G], scr, r / 64, r % 64, lane); continue; } r -= I_WUP;
        if (r < I_WDQ) { const float* W = (const float*)a.in[I_B_W_DQ]; transpose_item([=](int n) { return W + n; }, 768, 1024, (bf16*)(ws + WS_WDQ), nullptr, scr, r / 24, r % 24, lane); continue; } r -= I_WDQ;
        if (r < I_WUQ) { const float* W = (const float*)a.in[I_B_W_UQ];
            transpose_item([=](int n) { const int hh = n / 96, j = n - hh * 96; const int sc = j < 64 ? j : 64 + ((j - 64) & 1) * 16 + ((j - 64) >> 1); return W + hh * 96 + sc; }, 1536, 768, (bf16*)(ws + WS_WUQ), (const float*)a.in[I_B_Q_NORM_G], scr, r / 48, r % 48, lane); continue; } r -= I_WUQ;
        if (r < I_WO) { const float* W = (const float*)a.in[I_B_W_O]; transpose_item([=](int n) { return W + n; }, 1024, 1024, (bf16*)(ws + WS_WO1), nullptr, scr, r / 32, r % 32, lane); continue; } r -= I_WO;
        if (r < I_GU) { const int le = r >> 9, q = r & 511; const float* Wg = (const float*)a.in[I_EXP_W_GATE] + (size_t)le * 1024 * 512; const float* Wu = (const float*)a.in[I_EXP_W_UP] + (size_t)le * 1024 * 512;
            bf16* dst = (bf16*)(ws + WS_EW + (size_t)(le >> 4) * EW_LAYER) + (size_t)(le & 15) * 1024 * 1024;
            transpose_item([=](int n) { const int tt = n >> 8, u = (n >> 7) & 1, j = n & 127; return (u ? Wu : Wg) + tt * 128 + j; }, 512, 1024, dst, nullptr, scr, q / 32, q % 32, lane); continue; } r -= I_GU;
        { const int le = r >> 8, q = r & 255; const float* Wd = (const float*)a.in[I_EXP_W_DOWN] + (size_t)le * 512 * 1024;
            bf16* dst = (bf16*)(ws + WS_EW + (size_t)(le >> 4) * EW_LAYER + EW_D) + (size_t)(le & 15) * 1024 * 512;
            transpose_item([=](int n) { return Wd + n; }, 1024, 512, dst, nullptr, scr, q / 32, q % 32, lane); }
    }
    { const int* pos = (const int*)a.in[I_POS]; f32x2* tab = (f32x2*)(ws + WS_ROPE);
      for (int idx = gw * 64 + lane; idx < M * 16; idx += NGW * 64) { const int tok = idx >> 4, i = idx & 15;
          const float invf = exp2f(-(float)i * (13.287712379549449f / 16.0f)); const float ang = (float)pos[tok] * invf; tab[idx] = (f32x2){cosf(ang), sinf(ang)}; } }
}

template <int N> __device__ __forceinline__ float wave_reduce_multi(float (&v)[N], const int lane) {
    int n = N;
#pragma unroll
    for (int s = 32; n > 1; s >>= 1, n >>= 1) { const int half = n >> 1; const bool up = (lane & s) != 0;
#pragma unroll
        for (int i = 0; i < N / 2; ++i) if (i < half) { const float a = v[i], b = v[i + half]; const float send = up ? a : b, keep = up ? b : a; v[i] = keep + __shfl_xor(send, s); } }
    float r = v[0];
#pragma unroll
    for (int s = (64 / N) >> 1; s >= 1; s >>= 1) r += __shfl_xor(r, s);
    return r;
}

template <int MODE>
__device__ __forceinline__ void row_pass(const Args& a, LAS unsigned char* lds, const int vcu, const int G, const int wave, const int lane, const int tid) {
    constexpr int E = (MODE == 2) ? 32 : 16;
    constexpr bool COMBINE = (MODE == 2 || MODE == 4), PROJ = (MODE != 4), TWO = (MODE == 2);
    constexpr int LAYER = (MODE == 3 || MODE == 4) ? 1 : 0;
    unsigned char* ws = a.ws;
    LAS float* Wsm = (LAS float*)lds;
    LAS float* VA = (LAS float*)(lds + 131072);
    LAS float* VB = VA + 1024; LAS float* VA2 = VA + 2048; LAS float* VB2 = VA + 3072; LAS float* VG = VA + 4096;
    LAS float* RS = (LAS float*)(lds + 131072 + 20480);
    LAS int* LCNT = (LAS int*)(lds + 131072 + 20480 + 4096);
    LAS int* RREC = (LAS int*)(lds + 131072 + 20480 + 4096 + 256);
    LAS float* RW = (LAS float*)(lds + 131072 + 20480 + 4096 + 256 + 1024);
    if constexpr (PROJ) {
        const float* Wsrc; int ldw;
        if constexpr (MODE == 0) { Wsrc = (const float*)a.in[I_A_W_IN] + 3072; ldw = 3088; }
        else if constexpr (MODE == 2) { Wsrc = (const float*)a.in[I_KV_W_DOWN] + 256; ldw = 288; }
        else { Wsrc = (const float*)a.in[I_ROUTER_W]; ldw = 16; }
        for (int idx = tid; idx < 1024 * E; idx += NTHR) { const int k = idx / E, e = idx % E; const float v = Wsrc[(size_t)k * ldw + e];
            const int lk = (k >> 2) & 63, ridx = ((k >> 8) * 4 + (k & 3)) * 64 + lk; const int sw = (E == 16) ? ((lk >> 2) & 3) : ((lk >> 1) & 7);
            Wsm[ridx * E + (((e >> 2) ^ sw) << 2) + (e & 3)] = v; }
    }
    if constexpr (COMBINE) { if (tid == 0) { const int* cnt = (const int*)(ws + WS_CTL) + CW_CNT + LAYER * 16 * 64; int acc_ = 0;
            for (int e = 0; e < 16; ++e) { LCNT[e] = acc_; acc_ += (cnt[e * 64] + 255) >> 8; } } }
    for (int chunk = vcu; chunk < M / 64; chunk += G) {
        const int row0 = chunk * 64, b = row0 / SEQ;
        __syncthreads();
        for (int k = tid; k < 1024; k += NTHR) {
            if constexpr (MODE == 0) { VA[k] = ((const float*)a.in[I_A_NORM_G])[k] * (1.f + mod_value(a, b, 1024 + k)); VB[k] = mod_value(a, b, k); }
            if constexpr (MODE == 1 || MODE == 3) { VA[k] = ((const float*)a.in[I_FFN_NORM_G])[LAYER * 1024 + k] * (1.f + mod_value(a, b, LAYER * 6144 + 4096 + k)); VB[k] = mod_value(a, b, LAYER * 6144 + 3072 + k); }
            if constexpr (MODE == 2) { VA[k] = ((const float*)a.in[I_KV_NORM_G])[k] * (1.f + mod_value(a, b, 12288 + 1024 + k)); VB[k] = mod_value(a, b, 12288 + k);
                                       VA2[k] = ((const float*)a.in[I_B_NORM_G])[k] * (1.f + mod_value(a, b, 6144 + 1024 + k)); VB2[k] = mod_value(a, b, 6144 + k); }
            if constexpr (MODE == 4) { VA[k] = ((const float*)a.in[I_FINAL_NORM_G])[k]; }
            if constexpr (COMBINE) VG[k] = mod_value(a, b, LAYER * 6144 + 5120 + k);
        }
        if constexpr (MODE == 1 || MODE == 3) { if (tid < 32) LCNT[tid] = 0; }
        __syncthreads();
        const float* xsrc = (MODE == 0) ? (const float*)a.in[I_X] : (const float*)(ws + WS_XR);
        f32x4 xn[4]; u32x2 y0n[4], y1n[4];
#define RP_ISSUE(lr_) do { const int row_ = row0 + (lr_); const f32x4* xr_ = (const f32x4*)(xsrc + (size_t)row_ * D) + lane; \
            _Pragma("unroll") for (int j = 0; j < 4; ++j) xn[j] = xr_[64 * j]; \
            if constexpr (COMBINE) { const int4 rt_ = rtn; if ((lr_) + 1 < 64) rtn = ((const int4*)(ws + WS_ROUTE))[row_ + 1]; const int b0_ = LCNT[rt_.x], b1_ = LCNT[rt_.z]; \
                const u32x2* ya_ = (const u32x2*)((const bf16*)(ws + WS_Y) + (size_t)(b0_ * 256 + rt_.y) * D) + lane; const u32x2* yb_ = (const u32x2*)((const bf16*)(ws + WS_Y) + (size_t)(b1_ * 256 + rt_.w) * D) + lane; \
                _Pragma("unroll") for (int j = 0; j < 4; ++j) { y0n[j] = ya_[64 * j]; y1n[j] = yb_[64 * j]; } } } while (0)
        int4 rtn = make_int4(0, 0, 0, 0); if constexpr (COMBINE) rtn = ((const int4*)(ws + WS_ROUTE))[row0 + wave * 8];
        RP_ISSUE(wave * 8);
#pragma unroll 1
        for (int rr = 0; rr < 8; rr += 1) {
            float hx[1][16]; float pacc[1][E];
#pragma unroll
            for (int q = 0; q < 1; ++q) {
                const int lr = wave * 8 + rr + q, row = row0 + lr;
                f32x4 x[4]; u32x2 y0c[4], y1c[4];
#pragma unroll
                for (int j = 0; j < 4; ++j) { x[j] = xn[j]; if constexpr (COMBINE) { y0c[j] = y0n[j]; y1c[j] = y1n[j]; } }
                if (rr + 1 < 8) RP_ISSUE(lr + 1);
                if constexpr (COMBINE) {
#pragma unroll
                    for (int j = 0; j < 4; ++j) { const u32x2 p = y0c[j], r2 = y1c[j]; const f32x4 g = *(const LAS f32x4*)(VG + 256 * j + 4 * lane);
                        x[j][0] += g[0] * (bflo(p.x) + bflo(r2.x)); x[j][1] += g[1] * (bfhi(p.x) + bfhi(r2.x)); x[j][2] += g[2] * (bflo(p.y) + bflo(r2.y)); x[j][3] += g[3] * (bfhi(p.y) + bfhi(r2.y)); }
                    if constexpr (MODE == 2) { f32x4* xw = (f32x4*)((float*)(ws + WS_XR) + (size_t)row * D) + lane;
#pragma unroll
                        for (int j = 0; j < 4; ++j) xw[64 * j] = x[j]; }
                }
                float ss = 0.f;
#pragma unroll
                for (int j = 0; j < 4; ++j) ss += (x[j][0] * x[j][0] + x[j][1] * x[j][1]) + (x[j][2] * x[j][2] + x[j][3] * x[j][3]);
                const float rstd = rsqrtf(wave_sum(ss) * (1.f / D) + EPS);
                if constexpr (MODE == 4) {
                    f32x4* ow = (f32x4*)(a.out + (size_t)row * D) + lane;
#pragma unroll
                    for (int j = 0; j < 4; ++j) { const f32x4 g = *(const LAS f32x4*)(VA + 256 * j + 4 * lane); ow[64 * j] = x[j] * rstd * g; }
                } else {
                    bf16* Hout = (bf16*)(ws + WS_H);
                    u32x2* hw = (u32x2*)(Hout + (size_t)row * D) + lane;
#pragma unroll
                    for (int j = 0; j < 4; ++j) { const f32x4 A = *(const LAS f32x4*)(VA + 256 * j + 4 * lane), Bv = *(const LAS f32x4*)(VB + 256 * j + 4 * lane);
                        const f32x4 hv = x[j] * rstd * A + Bv; hx[q][4 * j] = hv[0]; hx[q][4 * j + 1] = hv[1]; hx[q][4 * j + 2] = hv[2]; hx[q][4 * j + 3] = hv[3];
                        u32x2 w; w.x = cvt_pk_bf16(hv[0], hv[1]); w.y = cvt_pk_bf16(hv[2], hv[3]); hw[64 * j] = w; }
                    if constexpr (TWO) { u32x2* hw2 = (u32x2*)((bf16*)(ws + WS_H1) + (size_t)row * D) + lane;
#pragma unroll
                        for (int j = 0; j < 4; ++j) { const f32x4 A = *(const LAS f32x4*)(VA2 + 256 * j + 4 * lane), Bv = *(const LAS f32x4*)(VB2 + 256 * j + 4 * lane);
                            const f32x4 hv = x[j] * rstd * A + Bv; u32x2 w; w.x = cvt_pk_bf16(hv[0], hv[1]); w.y = cvt_pk_bf16(hv[2], hv[3]); hw2[64 * j] = w; } }
                }
            }
            if constexpr (PROJ) {
#pragma unroll
                for (int q = 0; q < 1; ++q)
#pragma unroll
                    for (int e = 0; e < E; ++e) pacc[q][e] = 0.f;
                const int sw = (E == 16) ? ((lane >> 2) & 3) : ((lane >> 1) & 7);
#pragma unroll
                for (int ji = 0; ji < 16; ++ji) {
                    const LAS float* wrow = Wsm + (ji * 64 + lane) * E;
#pragma unroll
                    for (int c = 0; c < E / 4; ++c) { const f32x4 w4 = *(const LAS f32x4*)(wrow + ((c ^ sw) << 2));
#pragma unroll
                        for (int q = 0; q < 1; ++q) { const float hv = hx[q][ji]; pacc[q][4 * c] += hv * w4[0]; pacc[q][4 * c + 1] += hv * w4[1]; pacc[q][4 * c + 2] += hv * w4[2]; pacc[q][4 * c + 3] += hv * w4[3]; } }
                    asm volatile("" ::: "memory");
                }
#pragma unroll
                for (int q = 0; q < 1; ++q) {
                    const int lr = wave * 8 + rr + q, row = row0 + lr;
                    const float v = wave_reduce_multi<E>(pacc[q], lane);
                    if constexpr (MODE == 0) { const int e = (lane >> 2) & 15; const float z = v + ((const float*)a.in[I_A_B_F])[e];
                        const float lf = z < 0.f ? z - log1pf(__expf(z)) : -log1pf(__expf(-z));
                        if ((lane & 3) == 0) ((float*)(ws + WS_LF))[(size_t)row * 16 + e] = lf; }
                    if constexpr (MODE == 1 || MODE == 3) { const int e = (lane >> 2) & 15; if ((lane & 3) == 0) RS[lr * 16 + e] = v; }
                    if constexpr (MODE == 2) { const int e = (lane >> 1) & 31, i = e & 15; const float partner = __shfl_xor(v, 32);
                        const f32x2 cs = ((const f32x2*)(ws + WS_ROPE))[(size_t)row * 16 + i];
                        const float o = (e < 16) ? v * cs[0] - partner * cs[1] : v * cs[0] + partner * cs[1];
                        if ((lane & 1) == 0) ((bf16*)(ws + WS_KR))[(size_t)row * 32 + 2 * i + (e >> 4)] = (bf16)(cvt_pk_bf16(o, 0.f) & 0xffffu); }
                }
            }
        }
        if constexpr (MODE == 1 || MODE == 3) {
            asm volatile("s_waitcnt lgkmcnt(0)" ::: "memory");
            if (lane < 8) {
                const int lr = wave * 8 + lane; const float* rb = (const float*)a.in[I_ROUTER_BIAS];
                float sc[16], sel[16];
#pragma unroll
                for (int e = 0; e < 16; ++e) { const float z = RS[lr * 16 + e]; sc[e] = 1.f / (1.f + expf(-z)); sel[e] = sc[e] + rb[e]; }
                int gbest = 0; float gs_best = -INFINITY;
#pragma unroll
                for (int g = 0; g < 4; ++g) { float m1 = -INFINITY, m2 = -INFINITY;
#pragma unroll
                    for (int j = 0; j < 4; ++j) { const float s = sel[4 * g + j]; if (s > m1) { m2 = m1; m1 = s; } else if (s > m2) m2 = s; }
                    const float gsum = m1 + m2; if (gsum > gs_best) { gs_best = gsum; gbest = g; } }
                float s4[4], c4[4];
#pragma unroll
                for (int j = 0; j < 4; ++j) { float sv = 0.f, cv = 0.f;
#pragma unroll
                    for (int g = 0; g < 4; ++g) if (g == gbest) { sv = sel[4 * g + j]; cv = sc[4 * g + j]; }
                    s4[j] = sv; c4[j] = cv; }
                int i0 = 0;
#pragma unroll
                for (int j = 1; j < 4; ++j) if (s4[j] > s4[i0]) i0 = j;
                int i1 = (i0 == 0) ? 1 : 0;
#pragma unroll
                for (int j = 0; j < 4; ++j) if (j != i0 && j != i1 && s4[j] > s4[i1]) i1 = j;
                float w0 = 0.f, w1 = 0.f;
#pragma unroll
                for (int j = 0; j < 4; ++j) { if (j == i0) w0 = c4[j]; if (j == i1) w1 = c4[j]; }
                const float inv = 1.f / (w0 + w1);
                const int e0 = gbest * 4 + i0, e1 = gbest * 4 + i1;
                const int lp0 = __hip_atomic_fetch_add(LCNT + e0, 1, __ATOMIC_RELAXED, __HIP_MEMORY_SCOPE_WORKGROUP);
                const int lp1 = __hip_atomic_fetch_add(LCNT + e1, 1, __ATOMIC_RELAXED, __HIP_MEMORY_SCOPE_WORKGROUP);
                RREC[lr * 4 + 0] = e0; RREC[lr * 4 + 1] = lp0; RREC[lr * 4 + 2] = e1; RREC[lr * 4 + 3] = lp1; RW[lr * 2] = w0 * inv; RW[lr * 2 + 1] = w1 * inv;
            }
            __syncthreads();
            if (tid < 16) { int* cnt = (int*)(ws + WS_CTL) + CW_CNT + LAYER * 16 * 64; const int n = LCNT[tid];
                LCNT[16 + tid] = n ? __hip_atomic_fetch_add(cnt + tid * 64, n, RLX_AGENT) : 0; }
            __syncthreads();
            if (tid < 64) { const int row = row0 + tid; const int e0 = RREC[tid * 4], e1 = RREC[tid * 4 + 2]; const int p0 = LCNT[16 + e0] + RREC[tid * 4 + 1], p1 = LCNT[16 + e1] + RREC[tid * 4 + 3];
                int* list = (int*)(ws + WS_LIST); float* wl = (float*)(ws + WS_WLIST);
                list[(size_t)e0 * M + p0] = row; list[(size_t)e1 * M + p1] = row; wl[(size_t)e0 * M + p0] = RW[tid * 2]; wl[(size_t)e1 * M + p1] = RW[tid * 2 + 1];
                ((int4*)(ws + WS_ROUTE))[row] = make_int4(e0, p0, e1, p1); }
        }
    }
    __syncthreads();
#undef RP_ISSUE
}

namespace epi {
using pg8::Unit; using pg8::BM; using pg8::HALF;
__device__ __forceinline__ int opaque(int x) { asm volatile("" : "+v"(x)); return x; }
struct Bf16Split {
    static constexpr bool PERM = true;
    bf16* O; int ldc; int split_tiles; size_t split_stride; float scale0;
    __device__ __forceinline__ void operator()(const f32x4 (&acc)[2][2][4][2], const Unit& u, int wr, int wc, int fr, int fq) const {
        int pn = u.pn; bf16* base = O; float sc = 1.f;
        if (split_tiles) { const int t = pn / split_tiles; base += (size_t)t * split_stride; pn -= t * split_tiles; if (t == 0) sc = scale0; }
        const int row0 = u.pm * BM + opaque(wr * 64 + fr), col0 = pn * BM + wc * 32 + 8 * fq;
#pragma unroll
        for (int ai = 0; ai < 2; ++ai)
#pragma unroll
            for (int m = 0; m < 4; ++m) { bf16* rowp = base + (size_t)(row0 + ai * HALF + m * 16) * ldc + col0;
#pragma unroll
                for (int bj = 0; bj < 2; ++bj) { const f32x4 v0 = acc[ai][bj][m][0] * sc, v1 = acc[ai][bj][m][1] * sc;
                    u32x4 w; w.x = cvt_pk_bf16(v0[0], v0[1]); w.y = cvt_pk_bf16(v0[2], v0[3]); w.z = cvt_pk_bf16(v1[0], v1[1]); w.w = cvt_pk_bf16(v1[2], v1[3]);
                    *(u32x4*)(rowp + bj * HALF) = w; } }
    }
};
struct Resid {
    static constexpr bool PERM = false;
    const float* base; float* out; const float* gate;
    __device__ __forceinline__ void operator()(const f32x4 (&acc)[2][2][4][2], const Unit& u, int wr, int wc, int fr, int fq) const {
        const int b = (u.pm * BM) / SEQ; const int col0 = u.pn * BM + wc * 32 + 4 * fq; const int rb = opaque(wr * 64 + fr);
        f32x4 gv[2][2];
#pragma unroll
        for (int bj = 0; bj < 2; ++bj)
#pragma unroll
            for (int n = 0; n < 2; ++n) gv[bj][n] = *(const f32x4*)(gate + (size_t)b * MODN + col0 + bj * HALF + n * 16);
#pragma unroll
        for (int ai = 0; ai < 2; ++ai)
#pragma unroll
            for (int m = 0; m < 4; ++m) { const size_t off = (size_t)(u.pm * BM + ai * HALF + m * 16 + rb) * D + col0;
#pragma unroll
                for (int bj = 0; bj < 2; ++bj)
#pragma unroll
                    for (int n = 0; n < 2; ++n) { const f32x4 bs = *(const f32x4*)(base + off + bj * HALF + n * 16); *(f32x4*)(out + off + bj * HALF + n * 16) = bs + gv[bj][n] * acc[ai][bj][m][n]; } }
    }
};
struct GateUp {
    static constexpr bool PERM = true;
    bf16* act;
    __device__ __forceinline__ void operator()(const f32x4 (&acc)[2][2][4][2], const Unit& u, int wr, int wc, int fr, int fq) const {
        const int col0 = u.pn * 128 + wc * 32 + 8 * fq; const int rb = opaque(wr * 64 + fr);
#pragma unroll
        for (int ai = 0; ai < 2; ++ai)
#pragma unroll
            for (int m = 0; m < 4; ++m) { const size_t srow = (size_t)u.pm * BM + ai * HALF + m * 16 + rb; float r[8];
#pragma unroll
                for (int n = 0; n < 2; ++n)
#pragma unroll
                    for (int i = 0; i < 4; ++i) { const float g = acc[ai][0][m][n][i], up = acc[ai][1][m][n][i]; r[4 * n + i] = g * __builtin_amdgcn_rcpf(1.f + __builtin_amdgcn_exp2f(-g * LOG2E)) * up; }
                u32x4 w; w.x = cvt_pk_bf16(r[0], r[1]); w.y = cvt_pk_bf16(r[2], r[3]); w.z = cvt_pk_bf16(r[4], r[5]); w.w = cvt_pk_bf16(r[6], r[7]);
                *(u32x4*)(act + srow * DEXP + col0) = w; }
    }
};
struct Down {
    static constexpr bool PERM = true;
    bf16* Y; const float* wlist; const LAS int* tb; const LAS int* cn;
    __device__ __forceinline__ void operator()(const f32x4 (&acc)[2][2][4][2], const Unit& u, int wr, int wc, int fr, int fq) const {
        const int e = u.aux, mt = u.pm - tb[e], cnt = cn[e]; const int col0 = u.pn * BM + wc * 32 + 8 * fq; const int rb = opaque(wr * 64 + fr);
#pragma unroll
        for (int ai = 0; ai < 2; ++ai)
#pragma unroll
            for (int m = 0; m < 4; ++m) { const int lr = ai * HALF + m * 16 + rb, li = mt * BM + lr; const float w = li < cnt ? wlist[(size_t)e * M + li] : 0.f;
                bf16* rowp = Y + ((size_t)u.pm * BM + lr) * D + col0;
#pragma unroll
                for (int bj = 0; bj < 2; ++bj) { const f32x4 v0 = acc[ai][bj][m][0] * w, v1 = acc[ai][bj][m][1] * w;
                    u32x4 x; x.x = cvt_pk_bf16(v0[0], v0[1]); x.y = cvt_pk_bf16(v0[2], v0[3]); x.z = cvt_pk_bf16(v1[0], v1[1]); x.w = cvt_pk_bf16(v1[2], v1[3]);
                    *(u32x4*)(rowp + bj * HALF) = x; }
                asm volatile("" ::: "memory"); }
    }
};
struct LowRank {
    static constexpr bool PERM = true;
    bf16* O0; float* SS0; bf16* O1; float* SS1;
    __device__ __forceinline__ void operator()(const f32x4 (&acc)[2][2][4][2], const Unit& u, int wr, int wc, int fr, int fq) const {
        bf16* O = u.aux ? O1 : O0; float* SS = u.aux ? SS1 : SS0; const int ldc = u.aux ? QRANK : KVRANK;
        const int col0 = u.pn * BM + wc * 32 + 8 * fq; const int rb = opaque(wr * 64 + fr);
#pragma unroll
        for (int ai = 0; ai < 2; ++ai)
#pragma unroll
            for (int m = 0; m < 4; ++m) { const int row = u.pm * BM + ai * HALF + m * 16 + rb; float s = 0.f;
#pragma unroll
                for (int bj = 0; bj < 2; ++bj) { const f32x4 v0 = acc[ai][bj][m][0], v1 = acc[ai][bj][m][1];
                    s += (v0[0] * v0[0] + v0[1] * v0[1]) + (v0[2] * v0[2] + v0[3] * v0[3]) + (v1[0] * v1[0] + v1[1] * v1[1]) + (v1[2] * v1[2] + v1[3] * v1[3]);
                    u32x4 x; x.x = cvt_pk_bf16(v0[0], v0[1]); x.y = cvt_pk_bf16(v0[2], v0[3]); x.z = cvt_pk_bf16(v1[0], v1[1]); x.w = cvt_pk_bf16(v1[2], v1[3]);
                    *(u32x4*)(O + (size_t)row * ldc + col0 + bj * HALF) = x; }
                s += __shfl_xor(s, 16); s += __shfl_xor(s, 32);
                if (fq == 0) atomicAdd(SS + row, s);
                asm volatile("" ::: "memory"); }
    }
};
struct KvUp {
    static constexpr bool PERM = true;
    bf16* KN; bf16* V; const float* SS;
    __device__ __forceinline__ void operator()(const f32x4 (&acc)[2][2][4][2], const Unit& u, int wr, int wc, int fr, int fq) const {
        bf16* base = u.pn < 4 ? KN : V; const int col0 = (u.pn & 3) * BM + wc * 32 + 8 * fq; const int rb = opaque(wr * 64 + fr);
#pragma unroll
        for (int ai = 0; ai < 2; ++ai)
#pragma unroll
            for (int m = 0; m < 4; ++m) { const int row = u.pm * BM + ai * HALF + m * 16 + rb; const float rs = rsqrtf(SS[row] * (1.f / KVRANK) + EPS);
#pragma unroll
                for (int bj = 0; bj < 2; ++bj) { const f32x4 v0 = acc[ai][bj][m][0] * rs, v1 = acc[ai][bj][m][1] * rs;
                    u32x4 x; x.x = cvt_pk_bf16(v0[0], v0[1]); x.y = cvt_pk_bf16(v0[2], v0[3]); x.z = cvt_pk_bf16(v1[0], v1[1]); x.w = cvt_pk_bf16(v1[2], v1[3]);
                    *(u32x4*)(base + (size_t)row * D + col0 + bj * HALF) = x; }
                asm volatile("" ::: "memory"); }
    }
};
struct QUp {
    static constexpr bool PERM = true;
    bf16* Q; const float* SS; const f32x2* tab;
    __device__ __forceinline__ void operator()(const f32x4 (&acc)[2][2][4][2], const Unit& u, int wr, int wc, int fr, int fq) const {
        const int rb = opaque(wr * 64 + fr); const int cb = opaque(wc * 32 + 8 * fq);
#pragma unroll
        for (int ai = 0; ai < 2; ++ai)
#pragma unroll
            for (int m = 0; m < 4; ++m) { const int row = u.pm * BM + ai * HALF + m * 16 + rb; const float rs = rsqrtf(SS[row] * (1.f / QRANK) + EPS) * C2_MLA;
#pragma unroll
                for (int bj = 0; bj < 2; ++bj) { const int col0 = u.pn * BM + bj * HALF + cb; const int hq = col0 / 96, jj = col0 - hq * 96;
                    float v[8];
#pragma unroll
                    for (int n = 0; n < 2; ++n)
#pragma unroll
                        for (int i = 0; i < 4; ++i) v[4 * n + i] = acc[ai][bj][m][n][i] * rs;
                    if (jj >= 64) { const f32x4* tp = (const f32x4*)(tab + (size_t)row * 16 + ((jj - 64) >> 1)); const f32x4 t0 = tp[0], t1 = tp[1];
                        const float cs[4] = {t0[0], t0[2], t1[0], t1[2]}, sn[4] = {t0[1], t0[3], t1[1], t1[3]};
#pragma unroll
                        for (int p = 0; p < 4; ++p) { const float x1 = v[2 * p], x2 = v[2 * p + 1]; v[2 * p] = x1 * cs[p] - x2 * sn[p]; v[2 * p + 1] = x2 * cs[p] + x1 * sn[p]; } }
                    u32x4 x; x.x = cvt_pk_bf16(v[0], v[1]); x.y = cvt_pk_bf16(v[2], v[3]); x.z = cvt_pk_bf16(v[4], v[5]); x.w = cvt_pk_bf16(v[6], v[7]);
                    *(u32x4*)(Q + (size_t)row * QCAT + col0) = x; }
                asm volatile("" ::: "memory"); }
    }
};
}

template <bool GATHER> struct MoeOrder {
    static constexpr bool EARLY_AOFF = true;
    const LAS int* tb; const LAS int* cn; int G, c, nN; int K;
    const char* A; const char* Bt; size_t b_expert_bytes; const int* list;
    __device__ __forceinline__ bool next(int i, pg8::Unit& u) const {
        const long L = (long)i * G + c; const int total = tb[16] * nN; if (L >= total) return false;
        const int mg = (int)(L / nN), pn = (int)(L % nN); int e = 0;
#pragma unroll
        for (int x = 1; x < 16; ++x) if (mg >= tb[x]) e = x;
        u.pm = mg; u.pn = pn; u.aux = e; u.A = A; u.B = Bt + (size_t)e * b_expert_bytes + (size_t)pn * 256 * K * 2; return true;
    }
    __device__ __forceinline__ unsigned a_off(const pg8::Unit& u, int r, int cc) const {
        if constexpr (GATHER) { const int e = u.aux, li = (u.pm - tb[e]) * 256 + r; const int tok = li < cn[e] ? list[(size_t)e * M + li] : 0; return (unsigned)(tok * K + cc) * 2u; }
        return (unsigned)((u.pm * 256 + r) * K + cc) * 2u;
    }
};
struct LowRankOrder {
    static constexpr bool EARLY_AOFF = true;
    const char* A0; const char* B0; const char* A1; const char* B1; int G, c;
    __device__ __forceinline__ bool next(int i, pg8::Unit& u) const {
        const int L = i * G + c; if (L >= 256) return false;
        const int x = L & 7, j = L >> 3, sub = j & 3; u.pm = 8 * x + (j >> 2);
        if (sub == 0) { u.pn = 0; u.aux = 0; u.A = A0; u.B = B0; } else { u.pn = sub - 1; u.aux = 1; u.A = A1; u.B = B1 + (size_t)(sub - 1) * 256 * 1024 * 2; }
        return true;
    }
    __device__ __forceinline__ unsigned a_off(const pg8::Unit& u, int r, int cc) const { return (unsigned)((u.pm * 256 + r) * 1024 + cc) * 2u; }
};

constexpr int NPHASE = 17;
__global__ void __launch_bounds__(NTHR, 2) fwd_kernel(Args args) {
    extern __shared__ __attribute__((aligned(16))) unsigned char lds_raw[];
    LAS unsigned char* lds = (LAS unsigned char*)lds_raw;
    volatile LAS unsigned* MISC = (volatile LAS unsigned*)(lds + LDS_MISC);
#define PH_IDS int tid = threadIdx.x; asm volatile("" : "+v"(tid)); const int lane = tid & 63, wave = __builtin_amdgcn_readfirstlane(tid >> 6); const int gw = vcu * NWAVES + wave; (void)lane; (void)gw;
    const int G = gridDim.x; const int bx = blockIdx.x; const int vcu = (G % 8 == 0) ? (bx % 8) * (G / 8) + bx / 8 : bx;
    unsigned char* ws = args.ws;
    gu32* ctl = (gu32*)(ws + WS_CTL);
    for (int u = threadIdx.x; u < 256; u += NTHR) ((LAS unsigned*)(lds + LDS_MISC))[u] = 0u;
    __syncthreads();
    XcdBarrier bar = xcd_barrier_post((unsigned*)ctl + CW_BAR, MISC);
    const int lo = args.ph_lo, hi = args.ph_hi;
#ifndef PH_MASK
#define PH_MASK 0x1ffff
#endif
#define IN(k) (((PH_MASK >> (k)) & 1) && lo <= (k) && (k) < hi)
#ifndef REP_MASK
#define REP_MASK 0
#endif
#define REP(k) for (int rep_ = 0, nrep_ = (((REP_MASK >> (k)) & 1) ? 2 : 1); rep_ < nrep_; (++rep_ < nrep_) ? (xcd_barrier(bar), 0) : 0)
#define SEAM(k) do { if (IN(k) && IN((k) + 1)) xcd_barrier(bar); } while (0)
    const int NGW = G * NWAVES;
    const LAS int* TB = (const LAS int*)(lds + LDS_MISC + 64);
    const LAS int* CN = (const LAS int*)(lds + LDS_MISC + 192);
#define MOE_TABLES(L) do { __syncthreads(); if (threadIdx.x == 0) { const int* cnt = (const int*)(ws + WS_CTL) + CW_CNT + (L) * 16 * 64; int acc_ = 0; \
        LAS int* tbw = (LAS int*)(lds + LDS_MISC + 64); LAS int* cnw = (LAS int*)(lds + LDS_MISC + 192); \
        for (int e_ = 0; e_ < 16; ++e_) { const int c_ = cnt[e_ * 64]; tbw[e_] = acc_; cnw[e_] = c_; acc_ += (c_ + 255) >> 8; } tbw[16] = acc_; } __syncthreads(); } while (0)

    if (IN(0)) REP(0) { PH_IDS p0_prologue(args, lds, gw, NGW, wave, lane, tid); }
    SEAM(0);
    if (IN(1)) REP(1) { PH_IDS
        for (int idx = bx * NTHR + tid; idx < 8 * MODN; idx += G * NTHR) ((float*)(ws + WS_MODF))[idx] = mod_value(args, idx / MODN, idx % MODN);
        row_pass<0>(args, lds, vcu, G, wave, lane, tid);
    }
    SEAM(1);
    if (IN(2)) REP(2) { PH_IDS
        for (int task = gw; task < BATCH * NH; task += NGW) { const int b = task / NH, h = task % NH;
            const float* lf = (const float*)(ws + WS_LF) + ((size_t)b * SEQ + 32 * lane) * 16 + h; float v[32]; float run = 0.f;
#pragma unroll
            for (int i = 0; i < 32; ++i) { run += lf[(size_t)i * 16]; v[i] = run; }
            float incl = run;
#pragma unroll
            for (int o = 1; o < 64; o <<= 1) { const float t = __shfl_up(incl, o); if (lane >= o) incl += t; }
            const float excl = incl - run;
            u32x4* kb = (u32x4*)(ws + WS_KB) + ((size_t)b * SEQ + 32 * lane) * 16 + h;
#pragma unroll
            for (int i = 0; i < 32; ++i) { const float bias = -(v[i] + excl) * LOG2E; const unsigned b1 = cvt_pk_bf16(bias, 0.f) & 0xffffu; const float r1 = bias - __uint_as_float(b1 << 16);
                const unsigned b2 = cvt_pk_bf16(r1, 0.f) & 0xffffu; const float r2 = r1 - __uint_as_float(b2 << 16); const unsigned b3 = cvt_pk_bf16(r2, 0.f) & 0xffffu;
                kb[(size_t)i * 16] = (u32x4){b1 | (b2 << 16), b3, 0u, 0u}; }
        }
        pg8::StaticOrder S; S.init(ws + WS_H, ws + WS_WIN, M, 3072, 1024, G, bx);
        epi::Bf16Split E{(bf16*)(ws + WS_Q), D, 4, (size_t)16 * MiB, C2_FOX};
        pg8::gemm_phase<epi::Bf16Split, pg8::StaticOrder, true>(lds, 1024, S, E);
    }
    SEAM(2);
    if (IN(3)) REP(3) {
        const attn::Args T{(const bf16*)(ws + WS_Q), D, 64, (const bf16*)(ws + WS_K), (const char*)(ws + WS_KB), 256, 16, (const bf16*)(ws + WS_V), (bf16*)(ws + WS_H)};
        attn::attn_phase<0>((LAS char*)lds, T, vcu, G);
    }
    SEAM(3);
    if (IN(4)) REP(4) {
        pg8::StaticOrder S; S.init(ws + WS_H, ws + WS_WO0, M, 1024, 1024, G, bx);
        epi::Resid E{(const float*)args.in[I_X], (float*)(ws + WS_XR), (const float*)(ws + WS_MODF) + 2048};
        pg8::gemm_phase<epi::Resid, pg8::StaticOrder, false>(lds, 1024, S, E);
    }
    SEAM(4);
    if (IN(5)) REP(5) { PH_IDS row_pass<1>(args, lds, vcu, G, wave, lane, tid); }
    SEAM(5);
    if (IN(6)) REP(6) {
        MOE_TABLES(0);
        MoeOrder<true> S{TB, CN, G, bx, 4, 1024, (const char*)(ws + WS_H), (const char*)(ws + WS_EW), (size_t)1024 * 1024 * 2, (const int*)(ws + WS_LIST)};
        epi::GateUp E{(bf16*)(ws + WS_ACT)};
        pg8::gemm_phase<epi::GateUp, MoeOrder<true>, true>(lds, 1024, S, E);
    }
    SEAM(6);
    if (IN(7)) REP(7) {
        MOE_TABLES(0);
        MoeOrder<false> S{TB, CN, G, bx, 4, 512, (const char*)(ws + WS_ACT), (const char*)(ws + WS_EW + EW_D), (size_t)1024 * 512 * 2, nullptr};
        epi::Down E{(bf16*)(ws + WS_Y), (const float*)(ws + WS_WLIST), TB, CN};
        pg8::gemm_phase<epi::Down, MoeOrder<false>, true>(lds, 512, S, E);
    }
    SEAM(7);
    if (IN(8)) REP(8) { PH_IDS row_pass<2>(args, lds, vcu, G, wave, lane, tid); }
    SEAM(8);
    if (IN(9)) REP(9) {
        LowRankOrder S{(const char*)(ws + WS_HKV), (const char*)(ws + WS_WDN), (const char*)(ws + WS_H1), (const char*)(ws + WS_WDQ), G, bx};
        epi::LowRank E{(bf16*)(ws + WS_CKV), (float*)(ws + WS_SSKV), (bf16*)(ws + WS_CQ), (float*)(ws + WS_SSQ)};
        pg8::gemm_phase<epi::LowRank, LowRankOrder, false>(lds, 1024, S, E);
    }
    SEAM(9);
    if (IN(10)) REP(10) {
        { pg8::StaticOrder S; S.init(ws + WS_CKV, ws + WS_WUP, M, 2048, 256, G, bx);
          epi::KvUp E{(bf16*)(ws + WS_KN), (bf16*)(ws + WS_V2), (const float*)(ws + WS_SSKV)};
          pg8::gemm_phase<epi::KvUp, pg8::StaticOrder, true>(lds, 256, S, E); }
        { pg8::StaticOrder S; S.init(ws + WS_CQ, ws + WS_WUQ, M, 1536, 768, G, bx);
          epi::QUp E{(bf16*)(ws + WS_QCAT), (const float*)(ws + WS_SSQ), (const f32x2*)(ws + WS_ROPE)};
          pg8::gemm_phase<epi::QUp, pg8::StaticOrder, true>(lds, 768, S, E); }
    }
    SEAM(10);
    if (IN(11)) REP(11) {
        const attn::Args T{(const bf16*)(ws + WS_QCAT), QCAT, 96, (const bf16*)(ws + WS_KN), (const char*)(ws + WS_KR), 64, 0, (const bf16*)(ws + WS_V2), (bf16*)(ws + WS_O2)};
        attn::attn_phase<1>((LAS char*)lds, T, vcu, G);
    }
    SEAM(11);
    if (IN(12)) REP(12) {
        pg8::StaticOrder S; S.init(ws + WS_O2, ws + WS_WO1, M, 1024, 1024, G, bx);
        epi::Resid E{(const float*)(ws + WS_XR), (float*)(ws + WS_XR), (const float*)(ws + WS_MODF) + 6144 + 2048};
        pg8::gemm_phase<epi::Resid, pg8::StaticOrder, false>(lds, 1024, S, E);
    }
    SEAM(12);
    if (IN(13)) REP(13) { PH_IDS row_pass<3>(args, lds, vcu, G, wave, lane, tid); }
    SEAM(13);
    if (IN(14)) REP(14) {
        MOE_TABLES(1);
        MoeOrder<true> S{TB, CN, G, bx, 4, 1024, (const char*)(ws + WS_H), (const char*)(ws + WS_EW + EW_LAYER), (size_t)1024 * 1024 * 2, (const int*)(ws + WS_LIST)};
        epi::GateUp E{(bf16*)(ws + WS_ACT)};
        pg8::gemm_phase<epi::GateUp, MoeOrder<true>, true>(lds, 1024, S, E);
    }
    SEAM(14);
    if (IN(15)) REP(15) {
        MOE_TABLES(1);
        MoeOrder<false> S{TB, CN, G, bx, 4, 512, (const char*)(ws + WS_ACT), (const char*)(ws + WS_EW + EW_LAYER + EW_D), (size_t)1024 * 512 * 2, nullptr};
        epi::Down E{(bf16*)(ws + WS_Y), (const float*)(ws + WS_WLIST), TB, CN};
        pg8::gemm_phase<epi::Down, MoeOrder<false>, true>(lds, 512, S, E);
    }
    SEAM(15);
    if (IN(16)) REP(16) { PH_IDS row_pass<4>(args, lds, vcu, G, wave, lane, tid); }
#undef IN
#undef PH_IDS
#undef SEAM
#undef MOE_TABLES
}

#ifndef MK_CUTS
#define MK_CUTS 0
#endif
extern "C" void kernel_launch(void* const* d_in, const int* in_sizes, int n_in, void* d_out, int out_size, void* d_ws, size_t ws_size, hipStream_t stream) {
    static int grid = 0;
    if (grid == 0) {
        if (n_in != 27 || in_sizes[0] != M * D || out_size != M * D || ws_size < WS_END) { fprintf(stderr, "kernel_launch: unexpected shapes (n_in %d, in0 %d, out %d, ws %zu need %zu); nothing launched\n", n_in, n_in > 0 ? in_sizes[0] : -1, out_size, ws_size, (size_t)WS_END); grid = -1; return; }
        int dev = 0, cus = 0, per_cu = 0;
        if (hipGetDevice(&dev) != hipSuccess || hipDeviceGetAttribute(&cus, hipDeviceAttributeMultiprocessorCount, dev) != hipSuccess) { grid = -1; return; }
        if (hipFuncSetAttribute((const void*)fwd_kernel, hipFuncAttributeMaxDynamicSharedMemorySize, LDS_BYTES) != hipSuccess) { fprintf(stderr, "kernel_launch: hipFuncSetAttribute failed\n"); grid = -1; return; }
        if (hipOccupancyMaxActiveBlocksPerMultiprocessor(&per_cu, (const void*)fwd_kernel, NTHR, LDS_BYTES) != hipSuccess || per_cu < 1) { fprintf(stderr, "kernel_launch: occupancy query says %d\n", per_cu); }
        (void)hipGetLastError();
        grid = cus;
    }
    if (grid < 0) return;
    if (hipMemsetAsync((char*)d_ws + WS_CTL, 0, CTL_ZERO_BYTES, stream) != hipSuccess) return;
    Args a{};
    for (int i = 0; i < 27; ++i) a.in[i] = d_in[i];
    a.out = (float*)d_out; a.ws = (unsigned char*)d_ws;
#if MK_CUTS
    for (int p = 0; p < NPHASE; ++p) { a.ph_lo = p; a.ph_hi = p + 1; hipLaunchKernelGGL(fwd_kernel, dim3(grid), dim3(NTHR), LDS_BYTES, stream, a); }
#else
    a.ph_lo = 0; a.ph_hi = NPHASE; hipLaunchKernelGGL(fwd_kernel, dim3(grid), dim3(NTHR), LDS_BYTES, stream, a);
#endif
}
```
